# Optimizing an MI355X kernel written in HIP

```python
import math
import jax, jax.numpy as jnp
from jax import lax
import numpy as np

D_MODEL = 1024
BATCH = 8
SEQ = 8192
DEPTH = 1
DEC_BATCH = 8
DEC_SEQ = 2048
PAST_LEN = 128

GRID_W = 64
GDN_HEADS = 4
GDN_DK = 128
GDN_DV = 128
CONV_K = 5
CHUNK = 64
ATT_HEADS = 4
ATT_KV_HEADS = 2
ATT_HD = 128
ATT_GROUP = ATT_HEADS // ATT_KV_HEADS
Q_BLOCK = 128
ROPE_THETA = 10000.0
D_FF = 4 * D_MODEL
EPS = 1e-6

GDN_QK = GDN_HEADS * GDN_DK
GDN_VW = GDN_HEADS * GDN_DV
GDN_CONV_W = 2 * GDN_QK + GDN_VW
ATT_Q = ATT_HEADS * ATT_HD
ATT_KV = ATT_KV_HEADS * ATT_HD
MIX_WIDTH = GDN_VW + ATT_Q
IN_SIZES = (GDN_CONV_W, GDN_VW, GDN_HEADS, GDN_HEADS, GDN_HEADS, GDN_HEADS, ATT_Q, ATT_KV, ATT_KV)
IN_WIDTH = sum(IN_SIZES)

kernel_name = "hybrid_bidir_gdn_axial_gqa_encoder"


def _rmsnorm(x, w):
    xf = x.astype(jnp.float32)
    y = xf * lax.rsqrt(jnp.mean(xf * xf, axis=-1, keepdims=True) + EPS)
    return (y * w.astype(jnp.float32)).astype(x.dtype)


def _l2norm(x):
    return x * lax.rsqrt(jnp.sum(x * x, axis=-1, keepdims=True) + EPS)


def _split_cols(p):
    outs, off = [], 0
    for s in IN_SIZES:
        outs.append(p[..., off:off + s])
        off += s
    return outs


def _gated_delta_chunked(q, k, v, g, beta):
    B_, T, H, DK = q.shape
    DV = v.shape[-1]
    N = T // CHUNK

    def to_chunks(a):
        a = a.reshape((B_, N, CHUNK, H) + a.shape[3:])
        return jnp.moveaxis(a, 3, 1)

    qc, kc, vc = to_chunks(q), to_chunks(k), to_chunks(v)
    gc = jnp.cumsum(to_chunks(g), axis=-1)
    bc = to_chunks(beta)

    idx = jnp.arange(CHUNK)
    lower_incl = idx[:, None] >= idx[None, :]
    strict = idx[:, None] > idx[None, :]
    diff = gc[..., :, None] - gc[..., None, :]
    decay = jnp.where(lower_incl, jnp.exp(jnp.where(lower_incl, diff, 0.0)), 0.0)

    k_beta = kc * bc[..., None]
    v_beta = vc * bc[..., None]
    kk = jnp.einsum('bhnid,bhnjd->bhnij', k_beta, kc) * decay
    tri = jnp.eye(CHUNK, dtype=q.dtype) + jnp.where(strict, kk, 0.0)
    rhs = jnp.concatenate([v_beta, k_beta * jnp.exp(gc)[..., None]], axis=-1)
    sol = lax.linalg.triangular_solve(tri, rhs, left_side=True, lower=True, unit_diagonal=True)
    u = sol[..., :DV]
    w = sol[..., DV:]

    qk = jnp.einsum('bhnid,bhnjd->bhnij', qc, kc) * decay
    g_last = gc[..., -1]
    k_to_end = kc * jnp.exp(g_last[..., None] - gc)[..., None]
    q_dec = qc * jnp.exp(gc)[..., None]

    xs = tuple(jnp.moveaxis(a, 2, 0) for a in (q_dec, qk, u, w, k_to_end, g_last))

    def step(S, inp):
        q_d, a_qk, u_c, w_c, k_e, gl = inp
        v_new = u_c - jnp.einsum('bhcd,bhdv->bhcv', w_c, S)
        o = jnp.einsum('bhcd,bhdv->bhcv', q_d, S) + jnp.einsum('bhij,bhjv->bhiv', a_qk, v_new)
        S = S * jnp.exp(gl)[..., None, None] + jnp.einsum('bhcd,bhcv->bhdv', k_e, v_new)
        return S, o

    S0 = jnp.zeros((B_, H, DK, DV), q.dtype)
    _, o = lax.scan(step, S0, xs)
    o = jnp.moveaxis(o, 0, 2).reshape(B_, H, T, DV)
    return jnp.moveaxis(o, 1, 2)


def _gated_deltanet(qkv, z, b_f, b_b, a_f, a_b, conv_w, A_log_f, A_log_b, dt_bias_f, dt_bias_b, gdn_norm_w):
    B_, T, _ = qkv.shape
    qkv = lax.conv_general_dilated(qkv, conv_w[:, None, :].astype(qkv.dtype), window_strides=(1,),
                                   padding=[(CONV_K // 2, CONV_K // 2)],
                                   dimension_numbers=('NWC', 'WIO', 'NWC'),
                                   feature_group_count=GDN_CONV_W)
    qkv = jax.nn.silu(qkv).astype(jnp.float32)
    q = qkv[..., :GDN_QK].reshape(B_, T, GDN_HEADS, GDN_DK)
    k = qkv[..., GDN_QK:2 * GDN_QK].reshape(B_, T, GDN_HEADS, GDN_DK)
    v = qkv[..., 2 * GDN_QK:].reshape(B_, T, GDN_HEADS, GDN_DV)
    q = _l2norm(q) * (GDN_DK ** -0.5)
    k = _l2norm(k)

    def gates(b, a, A_log, dt_bias):
        beta = jax.nn.sigmoid(b.astype(jnp.float32))
        g = -jnp.exp(A_log.astype(jnp.float32)) * jax.nn.softplus(a.astype(jnp.float32) + dt_bias.astype(jnp.float32))
        return g, beta

    g_f, beta_f = gates(b_f, a_f, A_log_f, dt_bias_f)
    g_b, beta_b = gates(b_b, a_b, A_log_b, dt_bias_b)
    o_f = _gated_delta_chunked(q, k, v, g_f, beta_f)
    flip = lambda a: jnp.flip(a, axis=1)
    o_b = flip(_gated_delta_chunked(flip(q), flip(k), flip(v), flip(g_b), flip(beta_b)))
    o = o_f + o_b
    o = o * lax.rsqrt(jnp.mean(o * o, axis=-1, keepdims=True) + EPS) * gdn_norm_w.astype(jnp.float32)
    zz = z.astype(jnp.float32).reshape(B_, T, GDN_HEADS, GDN_DV)
    o = o * jax.nn.silu(zz)
    return o.reshape(B_, T, GDN_VW).astype(z.dtype)


def _rope_half(x, ang):
    m = ang.shape[-1]
    c = jnp.cos(ang)[:, None, :]
    s = jnp.sin(ang)[:, None, :]
    x1, x2 = x[..., :m], x[..., m:]
    return jnp.concatenate([x1 * c - x2 * s, x1 * s + x2 * c], axis=-1)


def _axial_rope(x, row_ang, col_ang):
    half = ATT_HD // 2
    xf = x.astype(jnp.float32)
    return jnp.concatenate([_rope_half(xf[..., :half], row_ang), _rope_half(xf[..., half:], col_ang)], axis=-1)


def _axial_gqa(qf, kf, vf, q_norm_w, k_norm_w):
    B_, T, _ = qf.shape
    rows = T // GRID_W
    row = jnp.repeat(jnp.arange(rows, dtype=jnp.float32), GRID_W)
    col = jnp.tile(jnp.arange(GRID_W, dtype=jnp.float32), rows)
    n_freq = ATT_HD // 4
    inv_freq = ROPE_THETA ** (-jnp.arange(n_freq, dtype=jnp.float32) / n_freq)
    row_ang = row[:, None] * inv_freq[None, :]
    col_ang = col[:, None] * inv_freq[None, :]

    q = _rmsnorm(qf.reshape(B_, T, ATT_HEADS, ATT_HD), q_norm_w)
    k = _rmsnorm(kf.reshape(B_, T, ATT_KV_HEADS, ATT_HD), k_norm_w)
    v = vf.reshape(B_, T, ATT_KV_HEADS, ATT_HD)
    q = _axial_rope(q, row_ang, col_ang).astype(vf.dtype)
    k = _axial_rope(k, row_ang, col_ang).astype(vf.dtype)
    scale = ATT_HD ** -0.5

    nb = T // Q_BLOCK
    qb = q.reshape(B_, nb, Q_BLOCK, ATT_KV_HEADS, ATT_GROUP, ATT_HD)
    qb = jnp.moveaxis(qb, 1, 0)

    def block(qi):
        s = jnp.einsum('bqkgd,btkd->bkgqt', qi, k).astype(jnp.float32) * scale
        p = jax.nn.softmax(s, axis=-1)
        return jnp.einsum('bkgqt,btkd->bqkgd', p.astype(v.dtype), v)

    o = lax.map(block, qb)
    return jnp.moveaxis(o, 0, 1).reshape(B_, T, ATT_Q)


def _layer(x, norm_mix_pre, w_in, conv_w, A_log_f, A_log_b, dt_bias_f, dt_bias_b, gdn_norm_w,
           q_norm_w, k_norm_w, w_out, norm_mix_post, norm_mlp_pre, w_up, w_down, norm_mlp_post):
    h = _rmsnorm(x, norm_mix_pre)
    p = h @ w_in
    qkv_a, z_a, b_f, b_b, a_f, a_b, q_b, k_b, v_b = _split_cols(p)
    o_a = _gated_deltanet(qkv_a, z_a, b_f, b_b, a_f, a_b, conv_w, A_log_f, A_log_b,
                          dt_bias_f, dt_bias_b, gdn_norm_w)
    o_b = _axial_gqa(q_b, k_b, v_b, q_norm_w, k_norm_w)
    mix = jnp.concatenate([o_a, o_b], axis=-1) @ w_out
    x = x + _rmsnorm(mix, norm_mix_post)
    hm = _rmsnorm(x, norm_mlp_pre)
    f = jnp.square(jax.nn.relu(hm @ w_up)) @ w_down
    return x + _rmsnorm(f, norm_mlp_post)


def setup_inputs(seed: int = 0) -> dict:
    key = jax.random.key(seed)
    ks = jax.random.split(key, 20)
    f32 = jnp.float32

    def gain(k, shape):
        return 1.0 + 0.1 * jax.random.normal(k, shape, f32)

    dt = jnp.exp(jax.random.uniform(ks[6], (DEPTH, 2, GDN_HEADS), f32, math.log(0.001), math.log(0.1)))
    dt_bias = dt + jnp.log(-jnp.expm1(-dt))
    A_log = jnp.log(jax.random.uniform(ks[7], (DEPTH, 2, GDN_HEADS), f32, 1.0, 16.0))
    return {
        "x_prompt": jax.random.normal(ks[0], (BATCH, SEQ, D_MODEL), f32),
        "x_sample": jax.random.normal(ks[1], (DEC_BATCH, DEC_SEQ, D_MODEL), f32),
        "norm_mix_pre": gain(ks[2], (DEPTH, D_MODEL)),
        "w_in": jax.random.normal(ks[3], (DEPTH, D_MODEL, IN_WIDTH), f32) * D_MODEL ** -0.5,
        "conv_w": jax.random.normal(ks[4], (DEPTH, CONV_K, GDN_CONV_W), f32) * CONV_K ** -0.5,
        "A_log_f": A_log[:, 0],
        "A_log_b": A_log[:, 1],
        "dt_bias_f": dt_bias[:, 0],
        "dt_bias_b": dt_bias[:, 1],
        "gdn_norm_w": gain(ks[8], (DEPTH, GDN_DV)),
        "q_norm_w": gain(ks[9], (DEPTH, ATT_HD)),
        "k_norm_w": gain(ks[10], (DEPTH, ATT_HD)),
        "w_out": jax.random.normal(ks[11], (DEPTH, MIX_WIDTH, D_MODEL), f32) * MIX_WIDTH ** -0.5,
        "norm_mix_post": gain(ks[12], (DEPTH, D_MODEL)),
        "norm_mlp_pre": gain(ks[13], (DEPTH, D_MODEL)),
        "w_up": jax.random.normal(ks[14], (DEPTH, D_MODEL, D_FF), f32) * D_MODEL ** -0.5,
        "w_down": jax.random.normal(ks[15], (DEPTH, D_FF, D_MODEL), f32) * D_FF ** -0.5,
        "norm_mlp_post": gain(ks[16], (DEPTH, D_MODEL)),
    }


def reference(x_prompt, x_sample, norm_mix_pre, w_in, conv_w, A_log_f, A_log_b, dt_bias_f, dt_bias_b,
              gdn_norm_w, q_norm_w, k_norm_w, w_out, norm_mix_post, norm_mlp_pre, w_up, w_down,
              norm_mlp_post):
    y_prompt = x_prompt
    y_sample = x_sample
    for l in range(DEPTH):
        args = (norm_mix_pre[l], w_in[l], conv_w[l], A_log_f[l], A_log_b[l], dt_bias_f[l], dt_bias_b[l],
                gdn_norm_w[l], q_norm_w[l], k_norm_w[l], w_out[l], norm_mix_post[l], norm_mlp_pre[l],
                w_up[l], w_down[l], norm_mlp_post[l])
        y_prompt = _layer(y_prompt, *args)
        y_sample = _layer(y_sample, *args)
    return (y_prompt, y_sample)
```

```cpp
#include <hip/hip_runtime.h>
#include <hip/hip_cooperative_groups.h>
#include <cstdio>
#include <cstdint>
#include <cstddef>
namespace cg = cooperative_groups;

#ifndef PROBE_MODE
#define PROBE_MODE 0
#endif
#ifndef ONE_LAUNCH
#define ONE_LAUNCH 1
#endif

#define DI __device__ __forceinline__
typedef unsigned short bf16_t;
typedef __attribute__((ext_vector_type(8))) short bf16x8;
typedef __attribute__((ext_vector_type(4))) short s16x4;
typedef __attribute__((ext_vector_type(4))) float f32x4;
typedef __attribute__((ext_vector_type(16))) float f32x16;
typedef __attribute__((ext_vector_type(4))) unsigned u32x4;
typedef __attribute__((ext_vector_type(2))) unsigned u32x2;

constexpr int DM = 1024, MTOK = 81920, MPROMPT = 65536, TP = 8192, TS = 2048;
constexpr int NIN = 3072;
constexpr int WIN_LD = 3088;
constexpr int DFF = 4096;
constexpr float EPS = 1e-6f;

constexpr size_t OFF_WT_IN = 0, OFF_WT_OUT = 6291456, OFF_WT_UP = 8388608, OFF_WT_DOWN = 16777216, OFF_GATES = 25165824,
                 OFF_CTR = 30408704, OFF_H = 31457280, OFF_P = 199229440, OFF_QKVC = 702545920, OFF_X1B = 870318080, OFF_KVC = 954204160, WS_END = 1038090240;

struct Params {
  const float *xp, *xs, *nmp, *w_in, *conv_w, *Alf, *Alb, *dtf, *dtb, *gnw, *qnw, *knw, *w_out, *nmpost, *nmlp, *w_up, *w_down, *nmlppost;
  float* out;
  bf16_t *wt_in, *wt_out, *wt_up, *wt_down;
  float* gates; float* rs2; float* rs1;
  bf16_t *h, *p, *qkvc, *of, *ob, *mix, *hm, *f, *f2, *x1b, *kvc, *mixed;
  unsigned* ctr;
};

constexpr int LDS_BYTES = 163840;
constexpr size_t PSEG_Z = (size_t)81920 * 1536, PSEG_Q = (size_t)81920 * 2048;

typedef __attribute__((ext_vector_type(2))) float f32x2;
typedef __attribute__((ext_vector_type(2))) __bf16 bf16x2_t;
DI unsigned cvtpk(float lo, float hi) { const f32x2 v = {lo, hi}; const bf16x2_t b = __builtin_convertvector(v, bf16x2_t); return __builtin_bit_cast(unsigned, b); }
DI float bflo(unsigned u) { return __uint_as_float(u << 16); }
DI float bfhi(unsigned u) { return __uint_as_float(u & 0xffff0000u); }
DI float bf2f(bf16_t b) { return __uint_as_float((unsigned)b << 16); }
DI bf16_t f2bf(float x) { return (bf16_t)(cvtpk(x, x) & 0xffffu); }
DI float shx(float v, int m, int lane) { return __int_as_float(__builtin_amdgcn_ds_bpermute((lane ^ m) << 2, __float_as_int(v))); }
DI unsigned shxu(unsigned v, int m, int lane) { return (unsigned)__builtin_amdgcn_ds_bpermute((lane ^ m) << 2, (int)v); }
template <int CTRL> DI float dppf(float v) { return __int_as_float(__builtin_amdgcn_update_dpp(0, __float_as_int(v), CTRL, 0xf, 0xf, true)); }
template <int CTRL, int ROWMASK, bool BOUND> DI float dppm(float v) { return __int_as_float(__builtin_amdgcn_update_dpp(0, __float_as_int(v), CTRL, ROWMASK, 0xf, BOUND)); }
DI float wave_scan_incl(float v) {
  v += dppm<0x111, 0xf, true>(v); v += dppm<0x112, 0xf, true>(v); v += dppm<0x114, 0xf, true>(v); v += dppm<0x118, 0xf, true>(v);
  v += dppm<0x142, 0xa, false>(v); v += dppm<0x143, 0xc, false>(v);
  return v;
}
DI float xsum_step(float v, int o) {
  switch (o) {
    case 1: return v + dppf<0xB1>(v);
    case 2: return v + dppf<0x4E>(v);
    case 4: return v + dppf<0x141>(v);
    case 8: return v + dppf<0x140>(v);
    case 16: { auto r = __builtin_amdgcn_permlane16_swap(__float_as_uint(v), __float_as_uint(v), false, false); return __uint_as_float(r[0]) + __uint_as_float(r[1]); }
    default: { auto r = __builtin_amdgcn_permlane32_swap(__float_as_uint(v), __float_as_uint(v), false, false); return __uint_as_float(r[0]) + __uint_as_float(r[1]); }
  }
}
DI float wave_sum(float v, int lane) {
  (void)lane;
#pragma unroll
  for (int o = 1; o <= 32; o <<= 1) v = xsum_step(v, o);
  return v;
}
DI float silu(float x) { return x / (1.f + __expf(-x)); }

constexpr int GBM = 256, GBN = 128, GBK = 64, G_A_BYTES = GBM * GBK * 2, G_B_BYTES = GBN * GBK * 2, G_STAGE = G_A_BYTES + G_B_BYTES;
DI int gswz(int row, int chunk) { return row * 128 + ((chunk ^ ((row >> 1) & 7)) << 4); }

template <class Epi>
DI void gemm_tile(const bf16_t* __restrict__ A, int lda, const bf16_t* __restrict__ Bt, int ldb, int K, int m0, int n0, char* lds, const Epi& epi, int tid_in) {
  const int tid = tid_in, wid = tid >> 6, lane = tid & 63, wm = wid >> 1, wn = wid & 1, fr = lane & 15, fq = lane >> 4;
  f32x4 acc[4][4];
#pragma unroll
  for (int a = 0; a < 4; ++a)
#pragma unroll
    for (int b = 0; b < 4; ++b) acc[a][b] = (f32x4){0.f, 0.f, 0.f, 0.f};
  const bf16_t* Ag = A + (size_t)m0 * lda;
  const bf16_t* Bg = Bt + (size_t)n0 * ldb;
  const int srow = tid >> 3, sc = tid & 7;
  u32x4 ra[4], rb[2];
#define G_LOAD(k0) do { _Pragma("unroll") for (int i = 0; i < 4; ++i) ra[i] = *(const u32x4*)(Ag + (size_t)(srow + 64 * i) * lda + (k0) + sc * 8); \
                        _Pragma("unroll") for (int i = 0; i < 2; ++i) rb[i] = *(const u32x4*)(Bg + (size_t)(srow + 64 * i) * ldb + (k0) + sc * 8); } while (0)
#define G_STORE(st) do { _Pragma("unroll") for (int i = 0; i < 4; ++i) *(u32x4*)((st) + gswz(srow + 64 * i, sc)) = ra[i]; \
                         _Pragma("unroll") for (int i = 0; i < 2; ++i) *(u32x4*)((st) + G_A_BYTES + gswz(srow + 64 * i, sc)) = rb[i]; } while (0)
  G_LOAD(0); G_STORE(lds); __syncthreads();
  const int nk = K / GBK;
  for (int kt = 0; kt < nk; ++kt) {
    char* cur = lds + (kt & 1) * G_STAGE;
    char* nxt = lds + ((kt + 1) & 1) * G_STAGE;
    if (kt + 1 < nk) G_LOAD((kt + 1) * GBK);
#pragma unroll
    for (int ks = 0; ks < 2; ++ks) {
      bf16x8 af[4], bfr[4];
#pragma unroll
      for (int mi = 0; mi < 4; ++mi) af[mi] = *(const bf16x8*)(cur + gswz(wm * 64 + mi * 16 + fr, ks * 4 + fq));
#pragma unroll
      for (int ni = 0; ni < 4; ++ni) bfr[ni] = *(const bf16x8*)(cur + G_A_BYTES + gswz(wn * 64 + ni * 16 + fr, ks * 4 + fq));
#pragma unroll
      for (int mi = 0; mi < 4; ++mi)
#pragma unroll
        for (int ni = 0; ni < 4; ++ni) acc[mi][ni] = __builtin_amdgcn_mfma_f32_16x16x32_bf16(bfr[ni], af[mi], acc[mi][ni], 0, 0, 0);
    }
    if (kt + 1 < nk) G_STORE(nxt);
    __syncthreads();
  }
#undef G_LOAD
#undef G_STORE
#pragma unroll
  for (int mi = 0; mi < 4; ++mi)
#pragma unroll
    for (int ni = 0; ni < 4; ++ni) epi(m0 + wm * 64 + mi * 16 + fr, n0 + wn * 64 + ni * 16 + fq * 4, acc[mi][ni]);
}

struct EpiBf16 {
  bf16_t* O; int ldo;
  DI void operator()(int m, int n, f32x4 v) const { u32x2 w; w.x = cvtpk(v[0], v[1]); w.y = cvtpk(v[2], v[3]); *(u32x2*)(O + (size_t)m * ldo + n) = w; }
};
struct EpiRelu2 {
  bf16_t* O; int ldo;
  DI void operator()(int m, int n, f32x4 v) const {
    float a = fmaxf(v[0], 0.f), b = fmaxf(v[1], 0.f), c = fmaxf(v[2], 0.f), d = fmaxf(v[3], 0.f);
    u32x2 w; w.x = cvtpk(a * a, b * b); w.y = cvtpk(c * c, d * d); *(u32x2*)(O + (size_t)m * ldo + n) = w; }
};

template <class Epi>
DI void gemm_phase(const bf16_t* A, int lda, const bf16_t* Bt, int K, int N, char* lds, const Epi& epi, int tid_in) {
  const int ntn = N / GBN, ntiles = (MTOK / GBM) * ntn;
  for (int t = blockIdx.x; t < ntiles; t += gridDim.x) {
    const int mt = t / ntn, nt = t % ntn;
    gemm_tile(A, lda, Bt, K, K, mt * GBM, nt * GBN, lds, epi, tid_in);
  }
}


namespace pg8 {
#define PG8_LAS __attribute__((address_space(3)))
constexpr int BM = 256, BK = 64, HALF = 128, HTB = HALF * BK * 2, STAGE_BYTES = 8 * HTB, NXCD = 8, WGM = 8;
__host__ __device__ __forceinline__ int lds_byte(int r, int c) { const int st = (r >> 4) * 2 + (c >> 5), rr = r & 15, cc = c & 31, ob = rr * 64 + cc * 2; return st * 1024 + (ob ^ (((ob >> 9) & 1) << 5)); }
__host__ __device__ __forceinline__ void stage_rc(int b, int& R, int& C) { const int st = b / 1024, sb = b % 1024, swz = sb ^ (((sb >> 9) & 1) << 5); R = (st >> 1) * 16 + swz / 64; C = (st & 1) * 32 + (swz % 64) / 2; }
__host__ __device__ __forceinline__ int perm32(int rho) { const int n = rho >> 4, i = rho & 15; return 8 * (i >> 2) + 4 * n + (i & 3); }
struct Unit { int pm, pn; };
struct Gemm { const bf16_t* A; const bf16_t* Bt; int M, N, K, lda; };
struct StaticOrder {
    int nM, nN, nwg, G, c;
    __host__ __device__ void init(int M, int N, int G_, int c_) { nM = M / BM; nN = N / BM; nwg = nM * nN; G = G_; c = c_; }
    __host__ __device__ bool next(int i, Unit& u) const {
        const long L = (long)i * G + c; if (L >= nwg) return false;
        int wgid = (int)L; { const int q = nwg / NXCD, r = nwg % NXCD, xcd = wgid % NXCD, off = wgid / NXCD; wgid = (xcd < r ? xcd * (q + 1) : r * (q + 1) + (xcd - r) * q) + off; }
        const int nig = WGM * nN, gid = wgid / nig, fm = gid * WGM, gsz = (nM - fm) < WGM ? (nM - fm) : WGM;
        u.pm = fm + ((wgid % nig) % gsz); u.pn = (wgid % nig) / gsz; return true;
    }
    __device__ __forceinline__ void a_ready(const Unit&) const {}
    __device__ __forceinline__ void done(const Unit&) const {}
};
template <int ACT  , bool SCALE  > struct EpiStore {
    static constexpr bool PERM = true, AFTER_DRAIN = false;
    bf16_t* O; int ldc;
    const float* rowsc;
    bf16_t* kv;
    __device__ __forceinline__ void operator()(const f32x4 (&acc)[2][2][4][2], const Unit& u, int wr, int wc, int fr, int fq) const {
        const int row0 = u.pm * BM + wr * 64 + fr, col0 = u.pn * BM + wc * 32 + 8 * fq;
        if (kv != nullptr && u.pn >= 10) {
            bf16_t* base = kv + (size_t)(u.pn - 10) * 2 * MTOK * 128 + wc * 32 + 8 * fq;
#pragma unroll
            for (int ai = 0; ai < 2; ++ai)
#pragma unroll
                for (int m = 0; m < 4; ++m) { const float rsl = SCALE ? rowsc[row0 + ai * HALF + m * 16] : 1.f;
#pragma unroll
                    for (int bj = 0; bj < 2; ++bj) {
                        const f32x4 v0 = acc[ai][bj][m][0] * rsl, v1 = acc[ai][bj][m][1] * rsl;
                        u32x4 w; w.x = cvtpk(v0[0], v0[1]); w.y = cvtpk(v0[2], v0[3]); w.z = cvtpk(v1[0], v1[1]); w.w = cvtpk(v1[2], v1[3]);
                        *(u32x4*)(base + ((size_t)bj * MTOK + (row0 + ai * HALF + m * 16)) * 128) = w; } }
            return;
        }
        bf16_t* Oseg = O; int ldseg = ldc, cseg = col0;
        if (kv != nullptr) { if (u.pn < 6) { ldseg = 1536; } else if (u.pn < 8) { Oseg = O + PSEG_Z; ldseg = 512; cseg = col0 - 1536; } else { Oseg = O + PSEG_Q; ldseg = 512; cseg = col0 - 2048; } }
#pragma unroll
        for (int ai = 0; ai < 2; ++ai)
#pragma unroll
            for (int m = 0; m < 4; ++m) { bf16_t* rowp = Oseg + (size_t)(row0 + ai * HALF + m * 16) * ldseg + cseg;
                float rs2 = 1.f; if (SCALE) { const float rs = rowsc[row0 + ai * HALF + m * 16]; rs2 = ACT == 1 ? rs * rs : rs; }
#pragma unroll
                for (int bj = 0; bj < 2; ++bj) { f32x4 v0 = acc[ai][bj][m][0], v1 = acc[ai][bj][m][1];
                    if (ACT == 1) {
#pragma unroll
                        for (int e = 0; e < 4; ++e) { const float a = fmaxf(v0[e], 0.f), b = fmaxf(v1[e], 0.f); v0[e] = a * a * rs2; v1[e] = b * b * rs2; } }
                    else if (SCALE) { v0 = v0 * rs2; v1 = v1 * rs2; }
                    u32x4 w; w.x = cvtpk(v0[0], v0[1]); w.y = cvtpk(v0[2], v0[3]); w.z = cvtpk(v1[0], v1[1]); w.w = cvtpk(v1[2], v1[3]);
                    *(u32x4*)(rowp + bj * HALF) = w; } }
    }
};
template <class Epi, class Sched, bool ALIGN_EPI = false, bool SP2 = false>
__device__ __forceinline__ void gemm_phase(PG8_LAS unsigned char* lds, const Gemm g, const Sched& S, const Epi& E, int tid_in) {
    const int tid = tid_in, wid = __builtin_amdgcn_readfirstlane(tid >> 6), lane = tid & 63, wr = wid >> 2, wc = wid & 3, fr = lane & 15, fq = lane >> 4;
    const int K = g.K, nt = K / BK;
    unsigned voffA[2], voffB[2];
#pragma unroll
    for (int i = 0; i < 2; ++i) { int R, C; stage_rc(tid * 16 + i * 8192, R, C); const int Rb = Epi::PERM ? ((R & ~31) + perm32(R & 31)) : R;
        voffA[i] = (unsigned)(R * g.lda + C) * 2u; voffB[i] = (unsigned)(Rb * K + C) * 2u; }
    const size_t kstep = (size_t)(BK * 2);
    const size_t hstepB = (size_t)HALF * K * 2, hstepA = (size_t)HALF * g.lda * 2;
    const size_t tstepB = 2 * hstepB, tstepA = 2 * hstepA;
    const unsigned ldsw = (unsigned)wid * 1024u;
    const int aoff = lds_byte(wr * 64 + fr, fq * 8), boff = lds_byte(wc * 32 + fr, fq * 8);
#define PG8_SA(b, h) (((b) * 2 + (h)) * HTB)
#define PG8_SB(b, h) ((4 + (b) * 2 + (h)) * HTB)
#define PG8_STAGE(bufoff, gbase, voff) do { _Pragma("unroll") for (int _i = 0; _i < 2; ++_i) \
        __builtin_amdgcn_global_load_lds((const unsigned*)((const char*)(gbase) + (voff)[_i]), (PG8_LAS unsigned*)(lds + (bufoff) + ldsw + _i * 8192), 16, 0, 0); } while (0)
#define PG8_LDA(dst, b, h) do { _Pragma("unroll") for (int m = 0; m < 4; ++m) _Pragma("unroll") for (int k = 0; k < 2; ++k) dst[m][k] = *(const PG8_LAS bf16x8*)(lds + PG8_SA(b, h) + aoff + m * 2048 + k * 1024); } while (0)
#define PG8_LDB(dst, b, h) do { _Pragma("unroll") for (int n = 0; n < 2; ++n) _Pragma("unroll") for (int k = 0; k < 2; ++k) dst[n][k] = *(const PG8_LAS bf16x8*)(lds + PG8_SB(b, h) + boff + n * 2048 + k * 1024); } while (0)
#define PG8_MMA(ai, bj, At, Bt) do { __builtin_amdgcn_s_setprio(1); _Pragma("unroll") for (int m = 0; m < 4; ++m) _Pragma("unroll") for (int n = 0; n < 2; ++n) _Pragma("unroll") for (int k = 0; k < 2; ++k) \
        acc[ai][bj][m][n] = __builtin_amdgcn_mfma_f32_16x16x32_bf16(Bt[n][k], At[m][k], acc[ai][bj][m][n], 0, 0, 0); __builtin_amdgcn_s_setprio(0); } while (0)
#define PG8_WAIT_V(n) asm volatile("s_waitcnt vmcnt(" #n ")" ::: "memory")
#define PG8_WAIT_L(n) asm volatile("s_waitcnt lgkmcnt(" #n ")" ::: "memory")
#define PG8_BAR __builtin_amdgcn_s_barrier()
#define PG8_SCHED __builtin_amdgcn_sched_barrier(0)
    Unit cur, nxt; int ui = 0;
    if (!S.next(0, cur)) return;
    f32x4 acc[2][2][4][2];
#pragma unroll
    for (int a = 0; a < 2; ++a)
#pragma unroll
        for (int b = 0; b < 2; ++b)
#pragma unroll
            for (int m = 0; m < 4; ++m)
#pragma unroll
                for (int n = 0; n < 2; ++n) acc[a][b][m][n] = (f32x4){0.f, 0.f, 0.f, 0.f};
    bf16x8 At[4][2], B0[2][2], B1[2][2];
    const char* cA = (const char*)g.A + (size_t)cur.pm * tstepA; const char* cB = (const char*)g.Bt + (size_t)cur.pn * tstepB;
    S.a_ready(cur);
    if constexpr (SP2) {
        PG8_STAGE(PG8_SB(0, 0), cB, voffB); PG8_STAGE(PG8_SB(0, 1), cB + hstepB, voffB); PG8_STAGE(PG8_SA(0, 0), cA, voffA); PG8_STAGE(PG8_SA(0, 1), cA + hstepA, voffA);
        if (wr == 1) PG8_BAR;
        PG8_WAIT_V(2); PG8_BAR;
        PG8_STAGE(PG8_SB(1, 0), cB + kstep, voffB); PG8_STAGE(PG8_SA(1, 0), cA + kstep, voffA); PG8_STAGE(PG8_SB(1, 1), cB + hstepB + kstep, voffB);
        PG8_WAIT_V(6); PG8_BAR;
    } else {
        PG8_STAGE(PG8_SB(0, 0), cB, voffB); PG8_STAGE(PG8_SA(0, 0), cA, voffA); PG8_STAGE(PG8_SB(0, 1), cB + hstepB, voffB); PG8_STAGE(PG8_SA(0, 1), cA + hstepA, voffA);
        if (wr == 1) PG8_BAR;
        PG8_WAIT_V(4); PG8_BAR;
        PG8_STAGE(PG8_SB(1, 0), cB + kstep, voffB); PG8_STAGE(PG8_SA(1, 0), cA + kstep, voffA); PG8_STAGE(PG8_SB(1, 1), cB + hstepB + kstep, voffB);
        PG8_WAIT_V(6); PG8_BAR;
    }
    for (;;) {
        const bool has_next = S.next(ui + 1, nxt);
        const char* nA = has_next ? (const char*)g.A + (size_t)nxt.pm * tstepA : cA; const char* nB = has_next ? (const char*)g.Bt + (size_t)nxt.pn * tstepB : cB;
        for (int t = 0; t < nt; t += 2) {
            const bool last = (t == nt - 2);
            const char* a1 = cA + (size_t)(t + 1) * kstep;
            const char* a2 = last ? nA : cA + (size_t)(t + 2) * kstep; const char* b2 = last ? nB : cB + (size_t)(t + 2) * kstep;
            const char* a3 = a2 + kstep; const char* b3 = b2 + kstep;
            if (last && has_next) S.a_ready(nxt);
            if constexpr (SP2) {
            PG8_LDB(B0, 0, 0); PG8_LDB(B1, 0, 1); PG8_SCHED; PG8_LDA(At, 0, 0); PG8_STAGE(PG8_SA(1, 1), a1 + hstepA, voffA);
            PG8_WAIT_V(8); PG8_WAIT_L(0); PG8_BAR; PG8_MMA(0, 0, At, B0); PG8_MMA(0, 1, At, B1); PG8_BAR; PG8_SCHED;
            PG8_LDA(At, 0, 1); PG8_STAGE(PG8_SB(0, 0), b2, voffB); PG8_STAGE(PG8_SB(0, 1), b2 + hstepB, voffB); PG8_STAGE(PG8_SA(0, 0), a2, voffA);
            PG8_WAIT_V(8); PG8_WAIT_L(0); PG8_BAR; PG8_MMA(1, 0, At, B0); PG8_MMA(1, 1, At, B1); PG8_BAR; PG8_SCHED;
            PG8_LDB(B0, 1, 0); PG8_LDB(B1, 1, 1); PG8_SCHED; PG8_LDA(At, 1, 0); PG8_STAGE(PG8_SA(0, 1), a2 + hstepA, voffA);
            PG8_WAIT_V(8); PG8_WAIT_L(0); PG8_BAR; PG8_MMA(0, 0, At, B0); PG8_MMA(0, 1, At, B1); PG8_BAR; PG8_SCHED;
            PG8_LDA(At, 1, 1); PG8_STAGE(PG8_SB(1, 0), b3, voffB); PG8_STAGE(PG8_SB(1, 1), b3 + hstepB, voffB); PG8_STAGE(PG8_SA(1, 0), a3, voffA);
            PG8_WAIT_V(8); PG8_WAIT_L(0); PG8_BAR; PG8_MMA(1, 0, At, B0); PG8_MMA(1, 1, At, B1); PG8_BAR; PG8_SCHED;
            } else {
            PG8_LDB(B0, 0, 0); PG8_SCHED; PG8_LDA(At, 0, 0); PG8_STAGE(PG8_SA(1, 1), a1 + hstepA, voffA);
            PG8_WAIT_L(8); PG8_BAR; PG8_WAIT_L(0); PG8_MMA(0, 0, At, B0); PG8_BAR; PG8_SCHED;
            PG8_LDB(B1, 0, 1); PG8_STAGE(PG8_SB(0, 0), b2, voffB);
            PG8_BAR; PG8_WAIT_L(0); PG8_MMA(0, 1, At, B1); PG8_BAR;
            PG8_LDA(At, 0, 1); PG8_STAGE(PG8_SA(0, 0), a2, voffA);
            PG8_BAR; PG8_WAIT_L(0); PG8_MMA(1, 0, At, B0); PG8_BAR; PG8_SCHED;
            PG8_STAGE(PG8_SB(0, 1), b2 + hstepB, voffB);
            PG8_WAIT_V(6); PG8_BAR; PG8_MMA(1, 1, At, B1); PG8_BAR;
            PG8_LDB(B0, 1, 0); PG8_SCHED; PG8_LDA(At, 1, 0); PG8_STAGE(PG8_SA(0, 1), a2 + hstepA, voffA);
            PG8_WAIT_L(8); PG8_BAR; PG8_WAIT_L(0); PG8_MMA(0, 0, At, B0); PG8_BAR; PG8_SCHED;
            PG8_LDB(B1, 1, 1); PG8_STAGE(PG8_SB(1, 0), b3, voffB);
            PG8_BAR; PG8_WAIT_L(0); PG8_MMA(0, 1, At, B1); PG8_BAR;
            PG8_LDA(At, 1, 1); PG8_STAGE(PG8_SA(1, 0), a3, voffA);
            PG8_BAR; PG8_WAIT_L(0); PG8_MMA(1, 0, At, B0); PG8_BAR; PG8_SCHED;
            PG8_STAGE(PG8_SB(1, 1), b3 + hstepB, voffB);
            PG8_WAIT_V(6); PG8_BAR; PG8_MMA(1, 1, At, B1); PG8_BAR;
            }
        }
        if constexpr (ALIGN_EPI) { if (wr == 0) PG8_BAR; }
        if constexpr (!Epi::AFTER_DRAIN) { E(acc, cur, wr, wc, fr, fq); S.done(cur); }
        if (!has_next) break;
#pragma unroll
        for (int a = 0; a < 2; ++a)
#pragma unroll
            for (int b = 0; b < 2; ++b)
#pragma unroll
                for (int m = 0; m < 4; ++m)
#pragma unroll
                    for (int n = 0; n < 2; ++n) acc[a][b][m][n] = (f32x4){0.f, 0.f, 0.f, 0.f};
        cur = nxt; cA = nA; cB = nB; ++ui;
        if constexpr (ALIGN_EPI) { if (wr == 1) PG8_BAR; }
    }
    PG8_WAIT_V(0);
    if constexpr (!ALIGN_EPI) { if (wr == 0) PG8_BAR; }
    PG8_BAR;
    if constexpr (Epi::AFTER_DRAIN) { E.fused(acc, cur, wr, wc, fr, fq, lds, wid, lane); S.done(cur); }
#undef PG8_SA
#undef PG8_SB
#undef PG8_STAGE
#undef PG8_LDA
#undef PG8_LDB
#undef PG8_MMA
#undef PG8_WAIT_V
#undef PG8_WAIT_L
#undef PG8_BAR
#undef PG8_SCHED
}
}
template <int ACT, bool SCALE = false> DI void gemm8(const bf16_t* A, int lda, const bf16_t* Bt, int K, int N, bf16_t* O, int ldc, char* lds, int tid_in, bf16_t* kv = nullptr, const float* rowsc = nullptr) {
  pg8::Gemm g{A, Bt, MTOK, N, K, lda};
  pg8::StaticOrder S; S.init(MTOK, N, (int)gridDim.x, (int)blockIdx.x);
  pg8::EpiStore<ACT, SCALE> E{O, ldc, rowsc, kv};
  pg8::gemm_phase<pg8::EpiStore<ACT, SCALE>, pg8::StaticOrder, true, true>((PG8_LAS unsigned char*)lds, g, S, E, tid_in);
}

DI void transpose_tile(const float* __restrict__ W, int ldw, int ncol0, bf16_t* __restrict__ Wt, int K, int k0, int n0, float* tile, int lane, const float* ksc = nullptr) {
  const int r = lane >> 4, c4 = (lane & 15) * 4;
  f32x4 v[16];
#pragma unroll
  for (int i = 0; i < 16; ++i) { v[i] = *(const f32x4*)(W + (size_t)(k0 + r + 4 * i) * ldw + ncol0 + c4); if (ksc != nullptr) v[i] = v[i] * ksc[k0 + r + 4 * i]; }
#pragma unroll
  for (int i = 0; i < 16; ++i) *(f32x4*)(tile + (r + 4 * i) * 68 + c4) = v[i];
#pragma unroll
  for (int kc = 0; kc < 8; ++kc) {
    float x[8];
#pragma unroll
    for (int j = 0; j < 8; ++j) x[j] = tile[(kc * 8 + j) * 68 + lane];
    u32x4 w; w.x = cvtpk(x[0], x[1]); w.y = cvtpk(x[2], x[3]); w.z = cvtpk(x[4], x[5]); w.w = cvtpk(x[6], x[7]);
    *(u32x4*)(Wt + (size_t)(n0 + lane) * K + k0 + kc * 8) = w;
  }
}

DI void phase0(const Params& P, char* lds, int tid_in) {
  const int tid = tid_in, wid = tid >> 6, lane = tid & 63;
  float* tile = (float*)lds + wid * (64 * 68);
  if (blockIdx.x == 0 && tid == 0) *P.ctr = 0u;
  for (int t = blockIdx.x * 8 + wid; t < 3072; t += gridDim.x * 8) {
    if (t < 768) { const int kt = t / 48, nt = t % 48, n0 = nt * 64; transpose_tile(P.w_in, WIN_LD, n0 < 2048 ? n0 : n0 + 16, P.wt_in, 1024, kt * 64, n0, tile, lane, P.nmp); }
    else if (t < 1024) { const int u = t - 768, kt = u / 16, nt = u % 16; transpose_tile(P.w_out, 1024, nt * 64, P.wt_out, 1024, kt * 64, nt * 64, tile, lane); }
    else if (t < 2048) { const int u = t - 1024, kt = u / 64, nt = u % 64; transpose_tile(P.w_up, 4096, nt * 64, P.wt_up, 1024, kt * 64, nt * 64, tile, lane, P.nmlp); }
    else { const int u = t - 2048, kt = u / 16, nt = u % 16; transpose_tile(P.w_down, 1024, nt * 64, P.wt_down, 4096, kt * 64, nt * 64, tile, lane); }
  }
  __syncthreads();
  float* Wg = (float*)lds;
  for (int i = tid; i < 1024 * 16; i += 512) { const int k = i >> 4, c = i & 15; Wg[c * 1024 + k] = P.w_in[(size_t)k * WIN_LD + 2048 + c] * P.nmp[k]; }
  __syncthreads();
  f32x4 nw[4];
#pragma unroll
  for (int j = 0; j < 4; ++j) nw[j] = *(const f32x4*)(P.nmp + j * 256 + lane * 4);
  const int nwaves = gridDim.x * 8;
#pragma unroll 1
  for (int m = (blockIdx.x * 8 + wid) * 2; m < MTOK; m += nwaves * 2) {
    const float* xr = m < MPROMPT ? P.xp + (size_t)m * DM : P.xs + (size_t)(m - MPROMPT) * DM;
    f32x4 x0[4], x1[4]; float ss0 = 0.f, ss1 = 0.f;
#pragma unroll
    for (int j = 0; j < 4; ++j) { x0[j] = __builtin_nontemporal_load((const f32x4*)(xr + j * 256 + lane * 4)); x1[j] = __builtin_nontemporal_load((const f32x4*)(xr + DM + j * 256 + lane * 4)); }
#pragma unroll
    for (int j = 0; j < 4; ++j) { ss0 += x0[j][0] * x0[j][0] + x0[j][1] * x0[j][1] + x0[j][2] * x0[j][2] + x0[j][3] * x0[j][3];
                                  ss1 += x1[j][0] * x1[j][0] + x1[j][1] * x1[j][1] + x1[j][2] * x1[j][2] + x1[j][3] * x1[j][3]; }
    float g0[16], g1[16];
#pragma unroll
    for (int c = 0; c < 16; ++c) { g0[c] = 0.f; g1[c] = 0.f; }
#pragma unroll
    for (int c = 0; c < 16; ++c) {
#pragma unroll
      for (int j = 0; j < 4; ++j) {
        const f32x4 w = *(const f32x4*)(Wg + c * 1024 + j * 256 + lane * 4);
        g0[c] += x0[j][0] * w[0] + x0[j][1] * w[1] + x0[j][2] * w[2] + x0[j][3] * w[3];
        g1[c] += x1[j][0] * w[0] + x1[j][1] * w[1] + x1[j][2] * w[2] + x1[j][3] * w[3];
      }
      if ((c & 3) == 3) asm volatile("" ::: "memory");
    }
    ss0 = wave_sum(ss0, lane); ss1 = wave_sum(ss1, lane);
    const float rs0 = rsqrtf(ss0 * (1.f / DM) + EPS), rs1 = rsqrtf(ss1 * (1.f / DM) + EPS);
    asm volatile("" ::: "memory");
#pragma unroll
    for (int j = 0; j < 4; ++j) {
      const f32x4 h0 = x0[j], h1 = x1[j];
      u32x2 a, b2; a.x = cvtpk(h0[0], h0[1]); a.y = cvtpk(h0[2], h0[3]); b2.x = cvtpk(h1[0], h1[1]); b2.y = cvtpk(h1[2], h1[3]);
      *(u32x2*)(P.h + (size_t)m * DM + j * 256 + lane * 4) = a; *(u32x2*)(P.h + (size_t)(m + 1) * DM + j * 256 + lane * 4) = b2;
    }
#define HALVE(G, N, MASK) do { const bool up_ = (lane & (MASK)) != 0; _Pragma("unroll") for (int k_ = 0; k_ < (N); ++k_) { \
      const float send_ = up_ ? G[k_] : G[k_ + (N)], keep_ = up_ ? G[k_ + (N)] : G[k_]; G[k_] = keep_ + shx(send_, (MASK), lane); } } while (0)
    HALVE(g0, 8, 32); HALVE(g1, 8, 32); HALVE(g0, 4, 16); HALVE(g1, 4, 16); HALVE(g0, 2, 8); HALVE(g1, 2, 8); HALVE(g0, 1, 4); HALVE(g1, 1, 4);
#undef HALVE
    float v0 = g0[0], v1 = g1[0];
    v0 += shx(v0, 2, lane); v1 += shx(v1, 2, lane); v0 += shx(v0, 1, lane); v1 += shx(v1, 1, lane);
    const int cc = ((lane >> 5) & 1) * 8 + ((lane >> 4) & 1) * 4 + ((lane >> 3) & 1) * 2 + ((lane >> 2) & 1);
    if ((lane & 3) < 2) {
      const int rsel = lane & 3;
      const float v = rsel == 0 ? v0 * rs0 : v1 * rs1;
      float r;
      if (cc < 8) r = 1.f / (1.f + __expf(-v));
      else {
        const int dir = (cc - 8) >> 2, hh = cc & 3;
        const float Al = dir ? P.Alb[hh] : P.Alf[hh], db = dir ? P.dtb[hh] : P.dtf[hh];
        const float z = v + db;
        const float sp = z > 20.f ? z : log1pf(expf(z));
        r = -expf(Al) * sp;
      }
      P.gates[(size_t)cc * MTOK + (m + rsel)] = r;
      if (lane < 2) P.rs1[m + rsel] = rsel == 0 ? rs0 : rs1;
    }
  }
}

DI void phase2(const Params& P, int tid_in) {
  const int tid = tid_in, wid = tid >> 6, lane = tid & 63;
  const int nwaves = gridDim.x * 8;
  constexpr int TB = 16;
  for (int item = blockIdx.x * 8 + wid; item < 1280 * 12; item += nwaves) {
    const int ci = item / 12, it = item % 12;
    const int hv = it + 6;
    const long m0 = (long)ci * 64;
    long sb, se;
    if (m0 < MPROMPT) { sb = (m0 / TP) * TP; se = sb + TP; } else { sb = MPROMPT + ((m0 - MPROMPT) / TS) * TS; se = sb + TS; }
    if (it < 6) {
      const int ghv = 2 * it + (lane >> 5), c4 = (lane & 31) * 4, col = ghv * 128 + c4;
      float w[5][4];
#pragma unroll
      for (int j = 0; j < 5; ++j) { const f32x4 wv = *(const f32x4*)(P.conv_w + j * 1536 + col); w[j][0] = wv[0]; w[j][1] = wv[1]; w[j][2] = wv[2]; w[j][3] = wv[3]; }
      u32x2 buf[TB + 4];
#pragma unroll
      for (int j = 0; j < 4; ++j) { const long r = m0 - 2 + j; buf[j] = (r >= sb && r < se) ? *(const u32x2*)(P.p + (size_t)r * 1536 + col) : (u32x2){0u, 0u}; }
      bf16_t* const obase = P.qkvc + ((size_t)(ghv & 3) * MTOK) * 384 + (ghv >> 2) * 128 + c4;
      for (int t0 = 0; t0 < 64; t0 += TB) {
#pragma unroll
        for (int j = 0; j < TB; ++j) { const long r = m0 + t0 + 2 + j; buf[4 + j] = (r >= sb && r < se) ? *(const u32x2*)(P.p + (size_t)r * 1536 + col) : (u32x2){0u, 0u}; }
        float av[TB][4];
#pragma unroll
        for (int t = 0; t < TB; ++t) {
          float x0 = 0.f, x1 = 0.f, x2 = 0.f, x3 = 0.f;
#pragma unroll
          for (int j = 0; j < 5; ++j) { x0 += bflo(buf[t + j].x) * w[j][0]; x1 += bfhi(buf[t + j].x) * w[j][1]; x2 += bflo(buf[t + j].y) * w[j][2]; x3 += bfhi(buf[t + j].y) * w[j][3]; }
          av[t][0] = silu(x0); av[t][1] = silu(x1); av[t][2] = silu(x2); av[t][3] = silu(x3);
        }
        if (it < 4) {
          float ss[TB];
#pragma unroll
          for (int t = 0; t < TB; ++t) ss[t] = (av[t][0] * av[t][0] + av[t][1] * av[t][1]) + (av[t][2] * av[t][2] + av[t][3] * av[t][3]);
#pragma unroll
          for (int o = 1; o <= 16; o <<= 1)
#pragma unroll
            for (int t = 0; t < TB; ++t) ss[t] = xsum_step(ss[t], o);
          const float hs = it < 2 ? 0.08838834764831845f : 1.f;
#pragma unroll
          for (int t = 0; t < TB; ++t) { const float sc = rsqrtf(ss[t] + EPS) * hs; av[t][0] *= sc; av[t][1] *= sc; av[t][2] *= sc; av[t][3] *= sc; }
        }
#pragma unroll
        for (int t = 0; t < TB; ++t) { u32x2 wv; wv.x = cvtpk(av[t][0], av[t][1]); wv.y = cvtpk(av[t][2], av[t][3]); *(u32x2*)(obase + (size_t)(m0 + t0 + t) * 384) = wv; }
#pragma unroll
        for (int j = 0; j < 4; ++j) buf[j] = buf[TB + j];
      }
    } else {
      const int ah = hv - 12;
      constexpr int TB = 32;
      bf16_t* const rbase = ah < 4 ? P.p + PSEG_Q + ah * 128 + lane * 2 : P.kvc + (size_t)(ah - 4) * MTOK * 128 + lane * 2;
      const size_t rstride = ah < 4 ? (size_t)512 : (size_t)128;
      const float* nwp = ah < 4 ? P.qnw : P.knw;
      const float nw0 = nwp[lane * 2], nw1 = nwp[lane * 2 + 1];
      const int i0 = (lane * 2) & 31;
      const float if0 = exp2f(-(float)i0 * (13.287712379549449f / 32.f)), if1 = exp2f(-(float)(i0 + 1) * (13.287712379549449f / 32.f));
      const float rowpos = (float)((m0 - sb) >> 6);
      const bool isx2 = (lane & 16) != 0, iscol = lane >= 32;
      for (int t0 = 0; t0 < 64; t0 += TB) {
        unsigned u[TB]; float a0[TB], a1[TB], ss[TB];
#pragma unroll
        for (int t = 0; t < TB; ++t) u[t] = *(const unsigned*)(rbase + (size_t)(m0 + t0 + t) * rstride);
#pragma unroll
        for (int t = 0; t < TB; ++t) { a0[t] = bflo(u[t]); a1[t] = bfhi(u[t]); ss[t] = a0[t] * a0[t] + a1[t] * a1[t]; }
#pragma unroll
        for (int o = 1; o <= 32; o <<= 1)
#pragma unroll
          for (int t = 0; t < TB; ++t) ss[t] = xsum_step(ss[t], o);
#pragma unroll
        for (int t = 0; t < TB; ++t) {
          const float rs = rsqrtf(ss[t] * (1.f / 128.f) + EPS);
          const float x0 = a0[t] * rs * nw0, x1 = a1[t] * rs * nw1;
          const float pos = iscol ? (float)(t0 + t) : rowpos;
          const float an0 = pos * if0, an1 = pos * if1;
          const float c0 = __cosf(an0), s0 = __sinf(an0), c1 = __cosf(an1), s1 = __sinf(an1);
          const float p0 = shx(x0, 16, lane), p1 = shx(x1, 16, lane);
          const float o0 = isx2 ? (p0 * s0 + x0 * c0) : (x0 * c0 - p0 * s0);
          const float o1 = isx2 ? (p1 * s1 + x1 * c1) : (x1 * c1 - p1 * s1);
          *(unsigned*)(rbase + (size_t)(m0 + t0 + t) * rstride) = cvtpk(o0, o1);
        }
      }
    }
  }
}

constexpr int AD = 128, ANW = 8, AQBLK = 32, AKVBLK = 64, LDQ = 512, LDK = 128, LDO = DM;
constexpr float ASCALE = 0.088388347648318440f, ATHR = 8.f;
constexpr size_t SHM_V = AKVBLK * AD * 2, SHM_K = AKVBLK * AD * 2;
#define KSWZ(row, colB) ((row) * 256 + ((colB) ^ (((row) & 7) << 4)))
#define SBAR() __builtin_amdgcn_sched_barrier(0)
DI int crow(int r, int hi) { return (r & 3) + 8 * (r >> 2) + 4 * hi; }
DI void partialSM(f32x16& p0, f32x16& p1, float& m_reg, float& mn, float& alpha) {
  constexpr float C = ASCALE * 1.4426950408889634f;
  float pmax = p0[0];
#pragma unroll
  for (int r = 1; r < 16; ++r) pmax = fmaxf(pmax, p0[r]);
#pragma unroll
  for (int r = 0; r < 16; ++r) pmax = fmaxf(pmax, p1[r]);
  { auto rr = __builtin_amdgcn_permlane32_swap(__float_as_uint(pmax), __float_as_uint(pmax), false, false);
    pmax = fmaxf(__uint_as_float(rr[0]), __uint_as_float(rr[1])); }
  if (__builtin_expect(__all(pmax - m_reg <= ATHR / ASCALE), 1)) { mn = m_reg; alpha = 1.f; }
  else { mn = fmaxf(m_reg, pmax); alpha = __builtin_amdgcn_exp2f((m_reg - mn) * C); m_reg = mn; }
  const float mnC = -mn * C;
#pragma unroll
  for (int r = 0; r < 16; ++r) p0[r] = fmaf(p0[r], C, mnC);
#pragma unroll
  for (int r = 0; r < 16; ++r) p1[r] = fmaf(p1[r], C, mnC);
#pragma unroll
  for (int r = 0; r < 16; ++r) p0[r] = __builtin_amdgcn_exp2f(p0[r]);
}
DI void finishSM(f32x16& p0, f32x16& p1, float alpha, float& l_reg, bf16x8& pa0, bf16x8& pa1, bf16x8& pa2, bf16x8& pa3) {
#pragma unroll
  for (int r = 0; r < 16; ++r) p1[r] = __builtin_amdgcn_exp2f(p1[r]);
  float ps = 0;
#pragma unroll
  for (int r = 0; r < 16; ++r) ps += p0[r];
#pragma unroll
  for (int r = 0; r < 16; ++r) ps += p1[r];
  { auto rr = __builtin_amdgcn_permlane32_swap(__float_as_uint(ps), __float_as_uint(ps), false, false);
    ps = __uint_as_float(rr[0]) + __uint_as_float(rr[1]); }
  l_reg = l_reg * alpha + ps;
#define PK4(Pv, BASE, OUT) do { unsigned a0 = cvtpk(Pv[BASE + 0], Pv[BASE + 1]), a1 = cvtpk(Pv[BASE + 2], Pv[BASE + 3]);   \
    unsigned b0 = cvtpk(Pv[BASE + 4], Pv[BASE + 5]), b1 = cvtpk(Pv[BASE + 6], Pv[BASE + 7]);                              \
    auto r0 = __builtin_amdgcn_permlane32_swap(a0, b0, false, false); auto r1 = __builtin_amdgcn_permlane32_swap(a1, b1, false, false); \
    u32x4 w = {r0[0], r1[0], r0[1], r1[1]}; OUT = *reinterpret_cast<bf16x8*>(&w); } while (0)
  PK4(p0, 0, pa0); PK4(p0, 8, pa1); PK4(p1, 0, pa2); PK4(p1, 8, pa3);
#undef PK4
}
DI void qkt(f32x16& p0, f32x16& p1, const char* Ks, const bf16x8* qr, int r32, int hi) {
#pragma unroll
  for (int r = 0; r < 16; ++r) { p0[r] = 0.f; p1[r] = 0.f; }
#pragma unroll
  for (int d0 = 0; d0 < 8; ++d0) { const int cb = (d0 * 16 + hi * 8) * 2;
    const bf16x8 b0 = *reinterpret_cast<const bf16x8*>(Ks + KSWZ(r32, cb));
    const bf16x8 b1 = *reinterpret_cast<const bf16x8*>(Ks + KSWZ(32 + r32, cb));
    p0 = __builtin_amdgcn_mfma_f32_32x32x16_bf16(b0, qr[d0], p0, 0, 0, 0);
    p1 = __builtin_amdgcn_mfma_f32_32x32x16_bf16(b1, qr[d0], p1, 0, 0, 0); }
}
DI int v_st(int k, int c) { const int kk = (k & ~0xC) | ((k & 4) << 1) | ((k & 8) >> 1); return ((kk >> 3) * 4 + (c >> 5)) * 512 + ((kk & 7) * 32 + (c & 31)) * 2; }
DI int v_rd_base(int lane) { return ((lane & 3) << 3) | (((lane >> 2) & 3) << 6) | (((lane >> 4) & 1) << 5) | (((lane >> 5) & 1) << 8); }
constexpr int v_rd_off(int d0, int ks, int half) { return d0 * 512 + ks * 4096 + half * 2048; }
template <int OFF> DI s16x4 tr_read(int vb) {
  s16x4 r; asm volatile("ds_read_b64_tr_b16 %0, %1 offset:%2" : "=&v"(r) : "v"(vb), "i"(OFF) : "memory"); return r;
}
template <int D0> DI void pv_one(f32x16& od, int vb, bf16x8 pa0, bf16x8 pa1, bf16x8 pa2, bf16x8 pa3) {
  const s16x4 l0 = tr_read<v_rd_off(D0, 0, 0)>(vb), h0 = tr_read<v_rd_off(D0, 0, 1)>(vb), l1 = tr_read<v_rd_off(D0, 1, 0)>(vb), h1 = tr_read<v_rd_off(D0, 1, 1)>(vb);
  const s16x4 l2 = tr_read<v_rd_off(D0, 2, 0)>(vb), h2 = tr_read<v_rd_off(D0, 2, 1)>(vb), l3 = tr_read<v_rd_off(D0, 3, 0)>(vb), h3 = tr_read<v_rd_off(D0, 3, 1)>(vb);
  asm volatile("s_waitcnt lgkmcnt(0)" ::: "memory"); SBAR();
#define PKV(L, H) (bf16x8){L[0], L[1], L[2], L[3], H[0], H[1], H[2], H[3]}
  od = __builtin_amdgcn_mfma_f32_32x32x16_bf16(pa0, PKV(l0, h0), od, 0, 0, 0);
  od = __builtin_amdgcn_mfma_f32_32x32x16_bf16(pa1, PKV(l1, h1), od, 0, 0, 0);
  od = __builtin_amdgcn_mfma_f32_32x32x16_bf16(pa2, PKV(l2, h2), od, 0, 0, 0);
  od = __builtin_amdgcn_mfma_f32_32x32x16_bf16(pa3, PKV(l3, h3), od, 0, 0, 0);
#undef PKV
}
DI void pv_d0(f32x16* o, int vb, bf16x8 pa0, bf16x8 pa1, bf16x8 pa2, bf16x8 pa3) {
  pv_one<0>(o[0], vb, pa0, pa1, pa2, pa3); pv_one<1>(o[1], vb, pa0, pa1, pa2, pa3); pv_one<2>(o[2], vb, pa0, pa1, pa2, pa3); pv_one<3>(o[3], vb, pa0, pa1, pa2, pa3);
}

DI void attn_unit(const bf16_t* __restrict__ Qb, const bf16_t* __restrict__ Kh, const bf16_t* __restrict__ Vh, bf16_t* __restrict__ Ob, int seq, char* lds, int tid_in) {
  const int tid = tid_in, wid = tid >> 6, lane = tid & 63, r32 = lane & 31, hi = lane >> 5;
  char* V_lds = lds; char* K_lds = lds + 2 * SHM_V;
  float* ws = (float*)(lds + 2 * SHM_V + 2 * SHM_K) + wid * 64; float* li_l = ws; float* al_l = ws + 32;
  float m_reg = -1e30f, l_reg = 0; f32x16 o[4]; bf16x8 qr[8];
#pragma unroll
  for (int d = 0; d < 4; ++d)
#pragma unroll
    for (int r = 0; r < 16; ++r) o[d][r] = 0.f;
  const bf16_t* Qw = Qb + (long)(wid * AQBLK + r32) * LDQ + hi * 8;
#pragma unroll
  for (int d0 = 0; d0 < 8; ++d0) qr[d0] = *(const bf16x8*)(Qw + d0 * 16);
  const int sr = tid >> 4, sc = (tid & 15) * 8, vst0 = v_st(sr, sc), vst1 = v_st(32 + sr, sc);
  const int vb0 = (int)(uintptr_t)V_lds + v_rd_base(lane);
  bf16x8 s0_vs0, s0_vs1, s0_ks0, s0_ks1, s1_vs0, s1_vs1, s1_ks0, s1_ks1;
  const unsigned koff = (unsigned)(sr * LDK + sc) * 2u;
  const char* const Kb = (const char*)Kh; const char* const Vb = (const char*)Vh;
#define SLOAD0(k0) do { const size_t tb = (size_t)(k0) * LDK * 2; \
    s0_vs0 = *(const bf16x8*)(Vb + tb + koff); s0_vs1 = *(const bf16x8*)(Vb + (tb + 32 * LDK * 2) + koff); \
    s0_ks0 = *(const bf16x8*)(Kb + tb + koff); s0_ks1 = *(const bf16x8*)(Kb + (tb + 32 * LDK * 2) + koff); } while (0)
#define SLOAD1(k0) do { const size_t tb = (size_t)(k0) * LDK * 2; \
    s1_vs0 = *(const bf16x8*)(Vb + tb + koff); s1_vs1 = *(const bf16x8*)(Vb + (tb + 32 * LDK * 2) + koff); \
    s1_ks0 = *(const bf16x8*)(Kb + tb + koff); s1_ks1 = *(const bf16x8*)(Kb + (tb + 32 * LDK * 2) + koff); } while (0)
#define SWRITE0(b) do { *(bf16x8*)(V_lds + (b) * SHM_V + vst0) = s0_vs0; *(bf16x8*)(V_lds + (b) * SHM_V + vst1) = s0_vs1; const int kc = sc * 2; \
    *(bf16x8*)(K_lds + (b) * SHM_K + KSWZ(sr, kc)) = s0_ks0; *(bf16x8*)(K_lds + (b) * SHM_K + KSWZ(32 + sr, kc)) = s0_ks1; } while (0)
#define SWRITE1(b) do { *(bf16x8*)(V_lds + (b) * SHM_V + vst0) = s1_vs0; *(bf16x8*)(V_lds + (b) * SHM_V + vst1) = s1_vs1; const int kc = sc * 2; \
    *(bf16x8*)(K_lds + (b) * SHM_K + KSWZ(sr, kc)) = s1_ks0; *(bf16x8*)(K_lds + (b) * SHM_K + KSWZ(32 + sr, kc)) = s1_ks1; } while (0)
#define SWAIT() asm volatile("s_waitcnt vmcnt(4)" ::: "memory")
#define RESC(a) do { if (__any((a) < 1.f)) { if (hi == 0) al_l[r32] = (a); asm volatile("s_waitcnt lgkmcnt(0)" ::: "memory"); \
    _Pragma("unroll") for (int d = 0; d < 4; ++d) _Pragma("unroll") for (int r = 0; r < 16; ++r) o[d][r] *= al_l[crow(r, hi)]; } } while (0)
  f32x16 pA0, pA1, pB0, pB1; float mnA, mnB, alA, alB; bf16x8 pa0, pa1, pa2, pa3; const int NT = seq / AKVBLK;
  SLOAD0(0); asm volatile("s_waitcnt vmcnt(0)" ::: "memory"); SWRITE0(0); __syncthreads();
  qkt(pA0, pA1, K_lds, qr, r32, hi); partialSM(pA0, pA1, m_reg, mnA, alA);
  SLOAD1(AKVBLK); if (2 < NT) SLOAD0(2 * AKVBLK);
  SWAIT(); SWRITE1(1); __syncthreads();
  if (__builtin_amdgcn_readfirstlane(wid) >= 4) __builtin_amdgcn_s_setprio(1);
  for (int j = 1; j + 1 < NT; j += 2) {
    SBAR(); qkt(pB0, pB1, K_lds + SHM_K, qr, r32, hi);
    finishSM(pA0, pA1, alA, l_reg, pa0, pa1, pa2, pa3); SBAR();
    SLOAD1((j + 2) * AKVBLK); SBAR();
    pv_d0(o, vb0, pa0, pa1, pa2, pa3); partialSM(pB0, pB1, m_reg, mnB, alB);
    __syncthreads(); SWAIT(); SWRITE0(0);
    RESC(alB); __syncthreads();
    SBAR(); qkt(pA0, pA1, K_lds, qr, r32, hi);
    finishSM(pB0, pB1, alB, l_reg, pa0, pa1, pa2, pa3); SBAR();
    if (j + 3 < NT) SLOAD0((j + 3) * AKVBLK); SBAR();
    pv_d0(o, vb0 + (int)SHM_V, pa0, pa1, pa2, pa3); partialSM(pA0, pA1, m_reg, mnA, alA);
    __syncthreads(); SWAIT(); SWRITE1(1);
    RESC(alA); __syncthreads();
  }
  SBAR(); qkt(pB0, pB1, K_lds + SHM_K, qr, r32, hi);
  finishSM(pA0, pA1, alA, l_reg, pa0, pa1, pa2, pa3); SBAR();
  pv_d0(o, vb0, pa0, pa1, pa2, pa3); partialSM(pB0, pB1, m_reg, mnB, alB);
  __syncthreads(); RESC(alB);
  finishSM(pB0, pB1, alB, l_reg, pa0, pa1, pa2, pa3); SBAR();
  pv_d0(o, vb0 + (int)SHM_V, pa0, pa1, pa2, pa3);
  if (hi == 0) li_l[r32] = l_reg; asm volatile("s_waitcnt lgkmcnt(0)" ::: "memory");
  float rli[16];
#pragma unroll
  for (int r = 0; r < 16; ++r) rli[r] = __builtin_amdgcn_rcpf(li_l[crow(r, hi)]);
  bf16_t* Ow = Ob + (long)(wid * AQBLK) * LDO;
#pragma unroll
  for (int r = 0; r < 16; ++r) { const int orow = crow(r, hi);
#pragma unroll
    for (int d0 = 0; d0 < 4; ++d0) Ow[(long)orow * LDO + d0 * 32 + r32] = f2bf(o[d0][r] * rli[r]); }
  __builtin_amdgcn_s_setprio(0);
#undef SLOAD0
#undef SLOAD1
#undef SWRITE0
#undef SWRITE1
#undef SWAIT
#undef RESC
  __syncthreads();
}

constexpr int RB64 = 144, RB128 = 272;
constexpr int L_KS = 0  , L_QS = 18432, L_KT = L_QS + 17408, L_VT = L_KT + 18432, L_TP = L_VT + 18432  ,
              L_QK = L_TP + 9216, L_AF = L_QK + 9216  , L_ST = L_AF + 17408, L_VS = L_ST + 34816  ,
              L_SM = L_VS + 18432, L_END = L_SM + 1344;
static_assert(L_END <= 163840, "LDS budget");
DI int swz128(int row, int chunk) { return row * RB64 + (chunk << 4); }
DI int swz256(int row, int chunk) { return row * RB128 + (chunk << 4); }
template <int RBA, int RBB, int KSTEPS> DI void mma_nt(f32x16& acc, const char* A, int arow, const char* Bt, int brow, int kh) {
#pragma unroll
  for (int s = 0; s < KSTEPS; ++s) {
    const int ch = 2 * s + kh;
    const bf16x8 a = *(const bf16x8*)(A + (RBA == 128 ? swz128(arow, ch) : swz256(arow, ch)));
    const bf16x8 b = *(const bf16x8*)(Bt + (RBB == 128 ? swz128(brow, ch) : swz256(brow, ch)));
    acc = __builtin_amdgcn_mfma_f32_32x32x16_bf16(a, b, acc, 0, 0, 0);
  }
}
DI bf16_t wordhalf(unsigned w, int h) { return (bf16_t)(h ? (w >> 16) : (w & 0xffffu)); }

DI void gdn_chain(const Params& P, int chain, char* lds, int tid_in) {
  const int tid = tid_in, wid = tid >> 6, lane = tid & 63, r32 = lane & 31, hi = lane >> 5;
  const int dir = chain & 1, head = (chain >> 1) & 3, seq = chain >> 3;
  const long base = seq < 8 ? (long)seq * TP : (long)MPROMPT + (long)(seq - 8) * TS;
  const int T = seq < 8 ? TP : TS, NC = T / 64;
  char* Ks = lds + L_KS; char* Qs = lds + L_QS; char* KT = lds + L_KT; char* VT = lds + L_VT; char* Tp = lds + L_TP; char* Tpp = lds + L_KS;
  char* QKm = lds + L_QK; char* NW = lds + L_AF; char* ST = lds + L_ST; char* VNT = lds + L_KS; char* VST = lds + L_VS;
  float* Af = (float*)(lds + L_AF); float* Tf = (float*)(lds + L_VS); float* Xs = (float*)(lds + L_TP);
  constexpr int AFS = 68;
  float* gcs = (float*)(lds + L_SM); float* betas = gcs + 64; float* egcs = gcs + 128; float* ees = gcs + 192; float* misc = gcs + 256;
  bf16_t* ob = dir ? P.ob : P.of;
  __syncthreads();
  for (int i = tid; i < 34816 / 16; i += 512) *(u32x4*)(ST + i * 16) = (u32x4){0u, 0u, 0u, 0u};
  f32x16 S0, S1;
#pragma unroll
  for (int r = 0; r < 16; ++r) { S0[r] = 0.f; S1[r] = 0.f; }
  const int lrow = lane, lch = wid * 2;
  u32x4 pq0, pq1, pk0, pk1, pv0, pv1; float pg = 0.f, pb = 0.f;
#define TOKOF(n, row) (base + (dir ? (long)(T - 1 - ((n) * 64 + (row))) : (long)((n) * 64 + (row))))
#define GLOADC(n) do { const long tk_ = TOKOF(n, lrow); const bf16_t* rp_ = P.qkvc + ((size_t)head * MTOK + (size_t)tk_) * 384 + lch * 8; \
    pq0 = *(const u32x4*)(rp_); pq1 = *(const u32x4*)(rp_ + 8); pk0 = *(const u32x4*)(rp_ + 128); pk1 = *(const u32x4*)(rp_ + 136); \
    pv0 = *(const u32x4*)(rp_ + 256); pv1 = *(const u32x4*)(rp_ + 264); \
    if (wid == 0) { pb = P.gates[(size_t)(dir * 4 + head) * MTOK + tk_]; pg = P.gates[(size_t)(8 + dir * 4 + head) * MTOK + tk_]; } } while (0)
  GLOADC(0);
  __syncthreads();
  for (int n = 0; n < NC; ++n) {
    int tidv = tid_in; asm volatile("" : "+v"(tidv));
    const int tid = tidv, lane = tid & 63, r32 = lane & 31, hi = lane >> 5, lrow = lane;
    *(u32x4*)(Ks + swz256(lrow, lch)) = pk0; *(u32x4*)(Ks + swz256(lrow, lch + 1)) = pk1;
    *(u32x4*)(Qs + swz256(lrow, lch)) = pq0; *(u32x4*)(Qs + swz256(lrow, lch + 1)) = pq1;
    {
      const bool odd = (lane & 1) != 0; const int rb = (lrow & ~1) * 2;
#pragma unroll
      for (int w = 0; w < 4; ++w) {
        const int d = lch * 8 + 2 * w + (odd ? 1 : 0);
        { const unsigned self = pk0[w], oth = shxu(self, 1, lane); *(unsigned*)(KT + d * RB64 + rb) = odd ? ((oth >> 16) | (self & 0xffff0000u)) : ((self & 0xffffu) | (oth << 16)); }
        { const unsigned self = pk1[w], oth = shxu(self, 1, lane); *(unsigned*)(KT + (d + 8) * RB64 + rb) = odd ? ((oth >> 16) | (self & 0xffff0000u)) : ((self & 0xffffu) | (oth << 16)); }
        { const unsigned self = pv0[w], oth = shxu(self, 1, lane); *(unsigned*)(VT + d * RB64 + rb) = odd ? ((oth >> 16) | (self & 0xffff0000u)) : ((self & 0xffffu) | (oth << 16)); }
        { const unsigned self = pv1[w], oth = shxu(self, 1, lane); *(unsigned*)(VT + (d + 8) * RB64 + rb) = odd ? ((oth >> 16) | (self & 0xffff0000u)) : ((self & 0xffffu) | (oth << 16)); }
      }
    }
    if (wid == 0) {
      const float c = wave_scan_incl(pg);
      const float gl = __int_as_float(__builtin_amdgcn_readlane(__float_as_int(c), 63));
      gcs[lane] = c; betas[lane] = pb; egcs[lane] = __expf(c); ees[lane] = __expf(gl - c); if (lane == 0) misc[0] = __expf(gl);
    }
    __syncthreads();
    {
      const int which = wid >> 2, mi = (wid >> 1) & 1, ni = wid & 1;
      f32x16 acc;
#pragma unroll
      for (int r = 0; r < 16; ++r) acc[r] = 0.f;
      if (which == 0) {
        if (mi >= ni) mma_nt<256, 256, 8>(acc, Ks, mi * 32 + r32, Ks, ni * 32 + r32, hi);
        const int j = ni * 32 + r32; const float gj = gcs[j];
#pragma unroll
        for (int r = 0; r < 16; ++r) {
          const int i = mi * 32 + crow(r, hi); const float dec = __expf(fminf(gcs[i] - gj, 0.f));
          Af[i * AFS + j] = (i > j) ? betas[i] * acc[r] * dec : 0.f;
        }
      } else {
        if (mi >= ni) mma_nt<256, 256, 8>(acc, Ks, ni * 32 + r32, Qs, mi * 32 + r32, hi);
        const int i = mi * 32 + r32; const float gi = gcs[i];
#pragma unroll
        for (int g = 0; g < 4; ++g) {
          const int j0 = ni * 32 + 8 * g + 4 * hi; float v[4];
#pragma unroll
          for (int e = 0; e < 4; ++e) { const int j = j0 + e; v[e] = (i >= j) ? acc[4 * g + e] * __expf(fminf(gi - gcs[j], 0.f)) : 0.f; }
          u32x2 w; w.x = cvtpk(v[0], v[1]); w.y = cvtpk(v[2], v[3]);
          *(u32x2*)(QKm + i * RB64 + j0 * 2) = w;
        }
      }
    }
    __syncthreads();
    if (wid == 0) {
      const int b = lane >> 4, c = lane & 15;
      const float* Ab = Af + (16 * b) * AFS + 16 * b;
      float t[16];
#pragma unroll
      for (int i = 0; i < 16; ++i) {
        float sacc = 0.f;
        asm volatile("" ::: "memory");
#pragma unroll
        for (int j4 = 0; j4 * 4 < i; ++j4) {
          const f32x4 a = *(const f32x4*)(Ab + i * AFS + j4 * 4);
#pragma unroll
          for (int e = 0; e < 4; ++e) if (j4 * 4 + e < i) sacc += a[e] * t[j4 * 4 + e];
        }
        t[i] = (i == c) ? 1.f : -sacc;
      }
#pragma unroll
      for (int i = 0; i < 16; ++i) Tf[(16 * b + i) * AFS + 16 * b + c] = t[i];
    } else {
      for (int e = tid - 64; e < 1536; e += 448) {
        const int blk = e >> 8, ii = (e >> 4) & 15, jj = e & 15;
        const int bi = blk < 3 ? 0 : (blk < 5 ? 1 : 2), bj = blk < 3 ? blk + 1 : (blk < 5 ? blk - 1 : 3);
        Tf[(16 * bi + ii) * AFS + 16 * bj + jj] = 0.f;
      }
    }
    __syncthreads();
#pragma unroll
    for (int d = 1; d <= 3; ++d) {
      const int nb = 4 - d;
      const int blk = tid >> 6, ii = (tid >> 2) & 15, j4 = (tid & 3) * 4, bi = blk + d, bj = blk;
      if (tid < nb * 64) {
        f32x4 sacc = (f32x4){0.f, 0.f, 0.f, 0.f};
        for (int bk = bj; bk < bi; ++bk)
#pragma unroll
          for (int k4 = 0; k4 < 4; ++k4) {
            const f32x4 a = *(const f32x4*)(Af + (16 * bi + ii) * AFS + 16 * bk + k4 * 4);
#pragma unroll
            for (int kk = 0; kk < 4; ++kk) sacc += a[kk] * *(const f32x4*)(Tf + (16 * bk + k4 * 4 + kk) * AFS + 16 * bj + j4);
          }
        *(f32x4*)(Xs + blk * 256 + ii * 16 + j4) = sacc;
      }
      __syncthreads();
      if (tid < nb * 64) {
        f32x4 sacc = (f32x4){0.f, 0.f, 0.f, 0.f};
#pragma unroll
        for (int k4 = 0; k4 < 4; ++k4) {
          const f32x4 a = *(const f32x4*)(Tf + (16 * bi + ii) * AFS + 16 * bi + k4 * 4);
#pragma unroll
          for (int kk = 0; kk < 4; ++kk) sacc += a[kk] * *(const f32x4*)(Xs + blk * 256 + (k4 * 4 + kk) * 16 + j4);
        }
        *(f32x4*)(Tf + (16 * bi + ii) * AFS + 16 * bj + j4) = -sacc;
      }
      __syncthreads();
    }
    {
      const int i = tid >> 3, c8 = tid & 7;
      const f32x4 t0 = *(const f32x4*)(Tf + i * AFS + c8 * 8), t1 = *(const f32x4*)(Tf + i * AFS + c8 * 8 + 4);
      const float tv[8] = {t0[0], t0[1], t0[2], t0[3], t1[0], t1[1], t1[2], t1[3]};
      u32x4 wp, wpp;
#pragma unroll
      for (int e = 0; e < 4; ++e) {
        const int j0 = c8 * 8 + 2 * e;
        const float a0 = tv[2 * e] * betas[j0], a1 = tv[2 * e + 1] * betas[j0 + 1];
        wp[e] = cvtpk(a0, a1); wpp[e] = cvtpk(a0 * egcs[j0], a1 * egcs[j0 + 1]);
      }
      *(u32x4*)(Tp + swz128(i, c8)) = wp; *(u32x4*)(Tpp + swz128(i, c8)) = wpp;
#pragma unroll
      for (int k = 0; k < 2; ++k) {
        const int c = tid + 512 * k, row = c >> 4, ch = c & 15; char* qp = Qs + swz256(row, ch);
        u32x4 v = *(u32x4*)qp; const float eg = egcs[row];
#pragma unroll
        for (int e = 0; e < 4; ++e) v[e] = cvtpk(bflo(v[e]) * eg, bfhi(v[e]) * eg);
        *(u32x4*)qp = v;
      }
    }
    __syncthreads();
    {
      const int mi = wid >> 2, ni = wid & 3;
      f32x16 acc;
#pragma unroll
      for (int r = 0; r < 16; ++r) acc[r] = 0.f;
      mma_nt<128, 128, 4>(acc, KT, ni * 32 + r32, Tpp, mi * 32 + r32, hi);
      const int i = mi * 32 + r32;
#pragma unroll
      for (int g = 0; g < 4; ++g) {
        const int dk0 = ni * 32 + 8 * g + 4 * hi;
        u32x2 w; w.x = cvtpk(-acc[4 * g], -acc[4 * g + 1]); w.y = cvtpk(-acc[4 * g + 2], -acc[4 * g + 3]);
        *(u32x2*)(NW + i * RB128 + dk0 * 2) = w;
      }
    }
    __syncthreads();
    if (n + 1 < NC) GLOADC(n + 1);
    {
      const int mi = wid >> 2, ni = wid & 3;
      f32x16 acc;
#pragma unroll
      for (int r = 0; r < 16; ++r) acc[r] = 0.f;
      mma_nt<128, 128, 4>(acc, Tp, mi * 32 + r32, VT, ni * 32 + r32, hi);
      mma_nt<256, 256, 8>(acc, NW, mi * 32 + r32, ST, ni * 32 + r32, hi);
      const int dv = ni * 32 + r32;
#pragma unroll
      for (int g = 0; g < 4; ++g) {
        const int i0 = mi * 32 + 8 * g + 4 * hi;
        u32x2 a, b;
        a.x = cvtpk(acc[4 * g], acc[4 * g + 1]); a.y = cvtpk(acc[4 * g + 2], acc[4 * g + 3]);
        b.x = cvtpk(acc[4 * g] * ees[i0], acc[4 * g + 1] * ees[i0 + 1]); b.y = cvtpk(acc[4 * g + 2] * ees[i0 + 2], acc[4 * g + 3] * ees[i0 + 3]);
        const int off = swz128(dv, i0 >> 3) + (i0 & 7) * 2;
        *(u32x2*)(VNT + off) = a; *(u32x2*)(VST + off) = b;
      }
    }
    __syncthreads();
    {
      const int mi = wid >> 2, ni = wid & 3;
      f32x16 acc;
#pragma unroll
      for (int r = 0; r < 16; ++r) acc[r] = 0.f;
      mma_nt<256, 256, 8>(acc, ST, ni * 32 + r32, Qs, mi * 32 + r32, hi);
      mma_nt<128, 128, 4>(acc, VNT, ni * 32 + r32, QKm, mi * 32 + r32, hi);
      {
        bf16_t* orow = ob + (size_t)TOKOF(n, mi * 32 + r32) * 512 + head * 128;
#pragma unroll
        for (int g = 0; g < 4; ++g) {
          const int dv0 = ni * 32 + 8 * g + 4 * hi;
          u32x2 w; w.x = cvtpk(acc[4 * g], acc[4 * g + 1]); w.y = cvtpk(acc[4 * g + 2], acc[4 * g + 3]);
          *(u32x2*)(orow + dv0) = w;
        }
      }
      const float egl = misc[0];
#pragma unroll
      for (int r = 0; r < 16; ++r) { S0[r] *= egl; S1[r] *= egl; }
      mma_nt<128, 128, 4>(S0, KT, (2 * mi) * 32 + r32, VST, ni * 32 + r32, hi);
      mma_nt<128, 128, 4>(S1, KT, (2 * mi + 1) * 32 + r32, VST, ni * 32 + r32, hi);
    }
    __syncthreads();
    {
      const int mi = wid >> 2, dv = (wid & 3) * 32 + r32;
#pragma unroll
      for (int g = 0; g < 4; ++g) {
        const int dk0 = (2 * mi) * 32 + 8 * g + 4 * hi, dk1 = dk0 + 32;
        u32x2 a, b;
        a.x = cvtpk(S0[4 * g], S0[4 * g + 1]); a.y = cvtpk(S0[4 * g + 2], S0[4 * g + 3]);
        b.x = cvtpk(S1[4 * g], S1[4 * g + 1]); b.y = cvtpk(S1[4 * g + 2], S1[4 * g + 3]);
        *(u32x2*)(ST + swz256(dv, dk0 >> 3) + (dk0 & 7) * 2) = a;
        *(u32x2*)(ST + swz256(dv, dk1 >> 3) + (dk1 & 7) * 2) = b;
      }
    }
  }
#undef TOKOF
#undef GLOADC
  __syncthreads();
}

DI int lane_id_now() { int l; asm volatile("v_mbcnt_lo_u32_b32 %0, -1, 0\n\tv_mbcnt_hi_u32_b32 %0, -1, %0" : "=v"(l)); return l; }
DI int grab_item(const Params& P, int* slot, int wsg) {
  __syncthreads();
  if (wsg == 0 && lane_id_now() == 0) *slot = (int)atomicAdd(P.ctr, 1u);
  __syncthreads();
  return __builtin_amdgcn_readfirstlane(*slot);
}
DI void phase3(const Params& P, char* lds, int tid_in, int limit) {
  int* slot = (int*)(lds + L_SM + 1280);
  const int wsg = __builtin_amdgcn_readfirstlane(tid_in >> 6);
  int w = grab_item(P, slot, wsg);
  while (w < 128) { gdn_chain(P, w, lds, wsg * 64 + lane_id_now()); w = grab_item(P, slot, wsg); }
  if (limit <= 128) return;
  asm volatile("" : "+s"(w));
  while (w < limit) {
    int u = w - 128; long base; int T, qb, head;
    if (u < 1024) { const int seq = u >> 7; head = ((u >> 6) & 1) * 2 + (u & 1); qb = (u >> 1) & 31; base = (long)seq * TP; T = TP; }
    else { u -= 1024; const int seq = u >> 5; head = ((u >> 4) & 1) * 2 + (u & 1); qb = (u >> 1) & 7; base = (long)MPROMPT + (long)seq * TS; T = TS; }
    const int kvh = head >> 1;
    const bf16_t* Qb = P.p + PSEG_Q + (size_t)(base + qb * 256) * 512 + head * 128;
    const bf16_t* Kh = P.kvc + ((size_t)kvh * MTOK + base) * 128;
    const bf16_t* Vh = P.kvc + ((size_t)(2 + kvh) * MTOK + base) * 128;
    bf16_t* Ob = P.mixed + (size_t)(base + qb * 256) * DM + 512 + head * 128;
    attn_unit(Qb, Kh, Vh, Ob, T, lds, wsg * 64 + lane_id_now());
    w = grab_item(P, slot, wsg);
  }
}

DI void phase3b(const Params& P, int tid_in) {
  const int tid = tid_in, wid = tid >> 6, lane = tid & 63, half = lane >> 5, c4 = (lane & 31) * 4;
  const int nwaves = gridDim.x * 8;
  const f32x4 gw = *(const f32x4*)(P.gnw + c4);
  constexpr int NB = 8;
  for (long it0 = (long)(blockIdx.x * 8 + wid) * (2 * NB); it0 < (long)MTOK * 4; it0 += (long)nwaves * (2 * NB)) {
    u32x2 uf[NB], ub[NB], uz[NB]; float o[NB][4], ss[NB];
#pragma unroll
    for (int k = 0; k < NB; ++k) {
      const long pr = it0 + 2 * k + half; const long m = pr >> 2; const int head = (int)(pr & 3);
      uf[k] = *(const u32x2*)(P.of + (size_t)m * 512 + head * 128 + c4);
      ub[k] = *(const u32x2*)(P.ob + (size_t)m * 512 + head * 128 + c4);
      uz[k] = *(const u32x2*)(P.p + PSEG_Z + (size_t)m * 512 + head * 128 + c4);
    }
#pragma unroll
    for (int k = 0; k < NB; ++k) {
      o[k][0] = bflo(uf[k].x) + bflo(ub[k].x); o[k][1] = bfhi(uf[k].x) + bfhi(ub[k].x); o[k][2] = bflo(uf[k].y) + bflo(ub[k].y); o[k][3] = bfhi(uf[k].y) + bfhi(ub[k].y);
      ss[k] = (o[k][0] * o[k][0] + o[k][1] * o[k][1]) + (o[k][2] * o[k][2] + o[k][3] * o[k][3]);
    }
#pragma unroll
    for (int os = 1; os <= 16; os <<= 1)
#pragma unroll
      for (int k = 0; k < NB; ++k) ss[k] = xsum_step(ss[k], os);
#pragma unroll
    for (int k = 0; k < NB; ++k) {
      const long pr = it0 + 2 * k + half; const long m = pr >> 2; const int head = (int)(pr & 3);
      const float rs = rsqrtf(ss[k] * (1.f / 128.f) + EPS);
      u32x2 w;
      w.x = cvtpk(o[k][0] * rs * gw[0] * silu(bflo(uz[k].x)), o[k][1] * rs * gw[1] * silu(bfhi(uz[k].x)));
      w.y = cvtpk(o[k][2] * rs * gw[2] * silu(bflo(uz[k].y)), o[k][3] * rs * gw[3] * silu(bfhi(uz[k].y)));
      *(u32x2*)(P.mixed + (size_t)m * DM + head * 128 + c4) = w;
    }
  }
}

DI void phase5(const Params& P, int tid_in) {
  const int tid = tid_in, wid = tid >> 6, lane = tid & 63;
  const int nwaves = gridDim.x * 8;
  f32x4 wp[4], wq[4];
#pragma unroll
  for (int j = 0; j < 4; ++j) { wp[j] = *(const f32x4*)(P.nmpost + j * 256 + lane * 4); wq[j] = *(const f32x4*)(P.nmlp + j * 256 + lane * 4); }
  for (int m = (blockIdx.x * 8 + wid) * 2; m < MTOK; m += nwaves * 2) {
    const float* xr = m < MPROMPT ? P.xp + (size_t)m * DM : P.xs + (size_t)(m - MPROMPT) * DM;
    f32x4 x[2][4], mx[2][4]; float ss[2] = {0.f, 0.f};
#pragma unroll
    for (int r = 0; r < 2; ++r)
#pragma unroll
      for (int j = 0; j < 4; ++j) {
        { const u32x2 ux = *(const u32x2*)(P.h + (size_t)(m + r) * DM + j * 256 + lane * 4); x[r][j] = (f32x4){bflo(ux.x), bfhi(ux.x), bflo(ux.y), bfhi(ux.y)}; }
        const u32x2 u = *(const u32x2*)(P.mix + (size_t)(m + r) * DM + j * 256 + lane * 4);
        mx[r][j] = (f32x4){bflo(u.x), bfhi(u.x), bflo(u.y), bfhi(u.y)};
      }
#pragma unroll
    for (int r = 0; r < 2; ++r)
#pragma unroll
      for (int j = 0; j < 4; ++j) ss[r] += mx[r][j][0] * mx[r][j][0] + mx[r][j][1] * mx[r][j][1] + mx[r][j][2] * mx[r][j][2] + mx[r][j][3] * mx[r][j][3];
#pragma unroll
    for (int o = 1; o <= 32; o <<= 1) { ss[0] = xsum_step(ss[0], o); ss[1] = xsum_step(ss[1], o); }
    float s2[2] = {0.f, 0.f};
#pragma unroll
    for (int r = 0; r < 2; ++r) {
      const float rs = rsqrtf(ss[r] * (1.f / DM) + EPS);
#pragma unroll
      for (int j = 0; j < 4; ++j) {
        x[r][j] = x[r][j] + mx[r][j] * rs * wp[j];
        { u32x2 wx; wx.x = cvtpk(x[r][j][0], x[r][j][1]); wx.y = cvtpk(x[r][j][2], x[r][j][3]); *(u32x2*)(P.x1b + (size_t)(m + r) * DM + j * 256 + lane * 4) = wx;
          x[r][j] = (f32x4){bflo(wx.x), bfhi(wx.x), bflo(wx.y), bfhi(wx.y)}; }
        s2[r] += x[r][j][0] * x[r][j][0] + x[r][j][1] * x[r][j][1] + x[r][j][2] * x[r][j][2] + x[r][j][3] * x[r][j][3];
      }
    }
#pragma unroll
    for (int o = 1; o <= 32; o <<= 1) { s2[0] = xsum_step(s2[0], o); s2[1] = xsum_step(s2[1], o); }
    if (lane < 2) P.rs2[m + lane] = rsqrtf((lane ? s2[1] : s2[0]) * (1.f / DM) + EPS);
  }
}

DI void phase8(const Params& P, int tid_in) {
  const int tid = tid_in, wid = tid >> 6, lane = tid & 63;
  const int nwaves = gridDim.x * 8;
  f32x4 wp[4];
#pragma unroll
  for (int j = 0; j < 4; ++j) wp[j] = *(const f32x4*)(P.nmlppost + j * 256 + lane * 4);
  for (int m = (blockIdx.x * 8 + wid) * 2; m < MTOK; m += nwaves * 2) {
    f32x4 x[2][4], mx[2][4]; float ss[2] = {0.f, 0.f};
#pragma unroll
    for (int r = 0; r < 2; ++r)
#pragma unroll
      for (int j = 0; j < 4; ++j) {
        { const u32x2 ux = *(const u32x2*)(P.x1b + (size_t)(m + r) * DM + j * 256 + lane * 4); x[r][j] = (f32x4){bflo(ux.x), bfhi(ux.x), bflo(ux.y), bfhi(ux.y)}; }
        const u32x2 u = *(const u32x2*)(P.f2 + (size_t)(m + r) * DM + j * 256 + lane * 4);
        mx[r][j] = (f32x4){bflo(u.x), bfhi(u.x), bflo(u.y), bfhi(u.y)};
      }
#pragma unroll
    for (int r = 0; r < 2; ++r)
#pragma unroll
      for (int j = 0; j < 4; ++j) ss[r] += mx[r][j][0] * mx[r][j][0] + mx[r][j][1] * mx[r][j][1] + mx[r][j][2] * mx[r][j][2] + mx[r][j][3] * mx[r][j][3];
#pragma unroll
    for (int o = 1; o <= 32; o <<= 1) { ss[0] = xsum_step(ss[0], o); ss[1] = xsum_step(ss[1], o); }
#pragma unroll
    for (int r = 0; r < 2; ++r) {
      const float rs = rsqrtf(ss[r] * (1.f / DM) + EPS);
#pragma unroll
      for (int j = 0; j < 4; ++j) __builtin_nontemporal_store(x[r][j] + mx[r][j] * rs * wp[j], (f32x4*)(P.out + (size_t)(m + r) * DM + j * 256 + lane * 4));
    }
  }
}


#define XB_TMO      128
#define XB_XCNT(j)  (256  + 64 * (j))
#define XB_XSUB(j)  (1280 + 64 * (j))
#define XB_XGEN(j)  (2304 + 64 * (j))
#define XB_TOP      3328
#define XB_TOPGEN   3392
#define XCD_BAR_WORDS 3456
#define XB_SPIN_CAP (1u << 18)
#define XLAS __attribute__((address_space(3)))
DI unsigned xb_ld(unsigned* p)              { return __hip_atomic_load(p, __ATOMIC_RELAXED, __HIP_MEMORY_SCOPE_AGENT); }
DI unsigned xb_add(unsigned* p, unsigned v) { return __hip_atomic_fetch_add(p, v, __ATOMIC_RELAXED, __HIP_MEMORY_SCOPE_AGENT); }
DI unsigned xb_xcc_id() { return (unsigned)__builtin_amdgcn_s_getreg((3 << 11) | 20) & 0xFu; }
#define XB_SPIN(cond, bar) do { unsigned _sp = 0; while (cond) { __builtin_amdgcn_s_sleep(1); \
    if ((++_sp & 255u) == 0u) { if (xb_ld(&(bar)[XB_TMO])) break; if (_sp > XB_SPIN_CAP) { atomicAdd(&(bar)[XB_TMO], 1u); break; } } } } while (0)
DI void xcd_barrier_complete(unsigned* bar, unsigned x, unsigned& nloc, unsigned& nx) {
  const unsigned G = gridDim.x * gridDim.y * gridDim.z;
  unsigned sum, cnt, mine, sp = 0u;
  for (;;) {
    sum = 0u; cnt = 0u; mine = 0u;
#pragma unroll
    for (unsigned j = 0; j < 16; ++j) { const unsigned c = xb_ld(&bar[XB_XCNT(j)]); sum += c; cnt += (c > 0u) ? 1u : 0u; mine = (j == x) ? c : mine; }
    if (sum == G) break;
    __builtin_amdgcn_s_sleep(1);
    if ((++sp & 255u) == 0u) { if (xb_ld(&bar[XB_TMO])) break; if (sp > XB_SPIN_CAP) { atomicAdd(&bar[XB_TMO], 1u); break; } }
  }
  nloc = mine > 0u ? mine : 1u; nx = cnt > 0u ? cnt : 1u;
}
DI void xcd_barrier(unsigned* bar, volatile XLAS unsigned* st, bool leader) {
  asm volatile("s_waitcnt vmcnt(0)" ::: "memory");
  __syncthreads();
  if (leader) {
    const unsigned x = xb_xcc_id();
    __builtin_amdgcn_s_waitcnt(0);
    unsigned nloc = st[0], nx = st[1];
    if (nloc == 0u) { xcd_barrier_complete(bar, x, nloc, nx); st[0] = nloc; st[1] = nx; }
    const unsigned old = xb_add(&bar[XB_XSUB(x)], 1u);
    const unsigned gen = old / nloc;
    if (old + 1u == (gen + 1u) * nloc) {
      __builtin_amdgcn_fence(__ATOMIC_RELEASE, "agent");
      asm volatile("s_waitcnt vmcnt(0)" ::: "memory");
      const unsigned og = xb_add(&bar[XB_TOP], 1u);
      const unsigned tg = og / nx;
      if (og + 1u == (tg + 1u) * nx) xb_add(&bar[XB_TOPGEN], 1u);
      else XB_SPIN(xb_ld(&bar[XB_TOPGEN]) == tg, bar);
      __builtin_amdgcn_fence(__ATOMIC_ACQUIRE, "agent");
      xb_add(&bar[XB_XGEN(x)], 1u);
      asm volatile("s_waitcnt vmcnt(0)" ::: "memory");
    } else {
      XB_SPIN(xb_ld(&bar[XB_XGEN(x)]) == gen, bar);
      __builtin_amdgcn_fence(__ATOMIC_ACQUIRE, "agent");
      asm volatile("s_waitcnt vmcnt(0)" ::: "memory");
    }
  }
  __syncthreads();
}

template <int PH> DI void run_phase(const Params& P, char* lds, int tid_in, int limit = 1408) {
  if constexpr (PH == 0) phase0(P, lds, tid_in);
  else if constexpr (PH == 1) gemm8<0, true>(P.h, DM, P.wt_in, DM, NIN, P.p, NIN, lds, tid_in, P.kvc, P.rs1);
  else if constexpr (PH == 2) phase2(P, tid_in);
  else if constexpr (PH == 3) phase3(P, lds, tid_in, limit);
  else if constexpr (PH == 4) phase3b(P, tid_in);
  else if constexpr (PH == 5) gemm8<0>(P.mixed, DM, P.wt_out, DM, DM, P.mix, DM, lds, tid_in);
  else if constexpr (PH == 6) phase5(P, tid_in);
  else if constexpr (PH == 7) gemm8<1, true>(P.x1b, DM, P.wt_up, DM, DFF, P.f, DFF, lds, tid_in, nullptr, P.rs2);
  else if constexpr (PH == 8) gemm8<0>(P.f, DFF, P.wt_down, DFF, DM, P.f2, DM, lds, tid_in);
  else if constexpr (PH == 9) phase8(P, tid_in);
  else if constexpr (PH == 10) { if (blockIdx.x == 0 && tid_in == 0) *P.ctr = (PROBE_MODE == 9) ? 128u : 0u; }
}

#if !ONE_LAUNCH
template <int PH> __global__ __launch_bounds__(512, 1) void phase_kernel(Params P) {
  extern __shared__ __attribute__((aligned(16))) char lds[];
  run_phase<PH>(P, lds, threadIdx.x);
}
#endif

#if ONE_LAUNCH
template <int PH> DI void mega_phase(char* lds, int wave_sgpr, int limit = 1408) {
#if defined(__HIP_DEVICE_COMPILE__)
  typedef const __attribute__((address_space(4))) unsigned long long* KWordPtr;
  KWordPtr pp = (KWordPtr)__builtin_amdgcn_kernarg_segment_ptr();
  asm volatile("" : "+s"(pp));
  constexpr int NW = sizeof(Params) / 8;
  union U { Params P; unsigned long long w[NW]; DI U() {} } u;
#pragma unroll
  for (int i = 0; i < NW; ++i) u.w[i] = pp[i];
  const Params& P = u.P;
  int lid;
  asm volatile("v_mbcnt_lo_u32_b32 %0, -1, 0\n\tv_mbcnt_hi_u32_b32 %0, -1, %0" : "=v"(lid));
  int tid = wave_sgpr * 64 + lid;
  asm volatile("" : "+v"(tid));
  run_phase<PH>(P, lds, tid, limit);
#endif
}
__global__ __launch_bounds__(512, 1) void mega_kernel(Params Pin) {
  extern __shared__ __attribute__((aligned(16))) char lds[];
  cg::grid_group grid = cg::this_grid();
  const int wave_sgpr = __builtin_amdgcn_readfirstlane((int)(threadIdx.x >> 6));
  volatile XLAS unsigned* xst = (volatile XLAS unsigned*)(XLAS unsigned char*)(lds + (LDS_BYTES - 16));
  if (threadIdx.x == 0) { xst[0] = 0u; xst[1] = 0u; (void)xb_add(&(Pin.ctr + 1024)[XB_XCNT(xb_xcc_id())], 1u); }
  __syncthreads();
#define GSYNC() do { typedef const __attribute__((address_space(4))) unsigned long long* KW_; KW_ pp_ = (KW_)__builtin_amdgcn_kernarg_segment_ptr(); asm volatile("" : "+s"(pp_)); \
    unsigned* bar_ = (unsigned*)pp_[offsetof(Params, ctr) / 8] + 1024; xcd_barrier(bar_, xst, wave_sgpr == 0 && lane_id_now() == 0); } while (0)
  if (Pin.out == nullptr) grid.sync();
  mega_phase<0>(lds, wave_sgpr); GSYNC();
  if (PROBE_MODE == 4 || PROBE_MODE == 5) { mega_phase<0>(lds, wave_sgpr); GSYNC(); }
  mega_phase<1>(lds, wave_sgpr); GSYNC();
  if (PROBE_MODE == 1) { mega_phase<1>(lds, wave_sgpr); GSYNC(); }
  mega_phase<2>(lds, wave_sgpr); GSYNC();
  {
    const int nrep = (PROBE_MODE == 3 || PROBE_MODE == 8 || PROBE_MODE == 9) ? ((Pin.ctr != nullptr) ? 2 : 1) : ((Pin.ctr != nullptr) ? 1 : 2);
    for (int rep = 0; rep < nrep; ++rep) {
      mega_phase<3>(lds, wave_sgpr, (rep == nrep - 1 || PROBE_MODE == 8 || PROBE_MODE == 9) ? 1408 : 128); GSYNC();
      if (rep < nrep - 1) { mega_phase<10>(lds, wave_sgpr); GSYNC(); }
    }
  }
  mega_phase<4>(lds, wave_sgpr); GSYNC();
  if (PROBE_MODE == 4) { mega_phase<4>(lds, wave_sgpr); GSYNC(); }
  mega_phase<5>(lds, wave_sgpr); GSYNC();
  if (PROBE_MODE == 1) { mega_phase<5>(lds, wave_sgpr); GSYNC(); }
  mega_phase<6>(lds, wave_sgpr); GSYNC();
  if (PROBE_MODE == 4 || PROBE_MODE == 6) { mega_phase<6>(lds, wave_sgpr); GSYNC(); }
  mega_phase<7>(lds, wave_sgpr); GSYNC();
  if (PROBE_MODE == 1) { mega_phase<7>(lds, wave_sgpr); GSYNC(); }
  mega_phase<8>(lds, wave_sgpr); GSYNC();
  if (PROBE_MODE == 1) { mega_phase<8>(lds, wave_sgpr); GSYNC(); }
  if (PROBE_MODE == 11) { for (int i = 0; i < 10; ++i) GSYNC(); }
  mega_phase<9>(lds, wave_sgpr);
  if (PROBE_MODE == 7) { grid.sync(); mega_phase<9>(lds, wave_sgpr); }
}
#endif

#if !ONE_LAUNCH
template <int PH> static void launch_phase(const Params& P, int grid, hipStream_t stream) {
  static bool attr = false;
  if (!attr) { (void)hipFuncSetAttribute((const void*)phase_kernel<PH>, hipFuncAttributeMaxDynamicSharedMemorySize, LDS_BYTES); attr = true; }
  hipLaunchKernelGGL(phase_kernel<PH>, dim3(grid), dim3(512), LDS_BYTES, stream, P);
}
#endif

extern "C" void kernel_launch(void* const* d_in, const int* in_sizes, int n_in, void* d_out, int out_size, void* d_ws, size_t ws_size, hipStream_t stream) {
  if (ws_size < WS_END) { fprintf(stderr, "kernel_launch: workspace too small: %zu < %zu\n", ws_size, WS_END); return; }
  Params P{};
  P.xp = (const float*)d_in[0]; P.xs = (const float*)d_in[1]; P.nmp = (const float*)d_in[2]; P.w_in = (const float*)d_in[3];
  P.conv_w = (const float*)d_in[4]; P.Alf = (const float*)d_in[5]; P.Alb = (const float*)d_in[6]; P.dtf = (const float*)d_in[7];
  P.dtb = (const float*)d_in[8]; P.gnw = (const float*)d_in[9]; P.qnw = (const float*)d_in[10]; P.knw = (const float*)d_in[11];
  P.w_out = (const float*)d_in[12]; P.nmpost = (const float*)d_in[13]; P.nmlp = (const float*)d_in[14]; P.w_up = (const float*)d_in[15];
  P.w_down = (const float*)d_in[16]; P.nmlppost = (const float*)d_in[17];
  P.out = (float*)d_out;
  char* ws = (char*)d_ws;
  P.wt_in = (bf16_t*)(ws + OFF_WT_IN); P.wt_out = (bf16_t*)(ws + OFF_WT_OUT); P.wt_up = (bf16_t*)(ws + OFF_WT_UP); P.wt_down = (bf16_t*)(ws + OFF_WT_DOWN);
  P.gates = (float*)(ws + OFF_GATES); P.ctr = (unsigned*)(ws + OFF_CTR); P.rs2 = (float*)(ws + OFF_CTR + 65536); P.rs1 = (float*)(ws + OFF_CTR + 65536 + 393216);
  P.h = (bf16_t*)(ws + OFF_H); P.of = (bf16_t*)d_out; P.ob = P.of + (size_t)MTOK * 512; P.mixed = P.of + (size_t)2 * MTOK * 512;         P.hm = P.h; P.f2 = P.h;
  P.p = (bf16_t*)(ws + OFF_P); P.f = P.p;
  P.qkvc = (bf16_t*)(ws + OFF_QKVC); P.mix = P.qkvc; P.x1b = (bf16_t*)(ws + OFF_X1B); P.kvc = (bf16_t*)(ws + OFF_KVC);
#if ONE_LAUNCH
  (void)hipMemsetAsync(ws + OFF_CTR, 0, 4096 + XCD_BAR_WORDS * 4, stream);
  static int grid_blocks = 0;
  if (!grid_blocks) {
    int dev = 0, cus = 0, per_cu = 0;
    (void)hipGetDevice(&dev);
    (void)hipDeviceGetAttribute(&cus, hipDeviceAttributeMultiprocessorCount, dev);
    (void)hipFuncSetAttribute((const void*)mega_kernel, hipFuncAttributeMaxDynamicSharedMemorySize, LDS_BYTES);
    (void)hipOccupancyMaxActiveBlocksPerMultiprocessor(&per_cu, mega_kernel, 512, LDS_BYTES);
    if (per_cu < 1) per_cu = 1;
    grid_blocks = cus * per_cu;
  }
  void* args[] = {&P};
  hipError_t e = hipLaunchCooperativeKernel((void*)mega_kernel, dim3(grid_blocks), dim3(512), args, LDS_BYTES, stream);
  if (e != hipSuccess) fprintf(stderr, "cooperative launch failed: %s (grid %d)\n", hipGetErrorString(e), grid_blocks);
#else
  const int grid = 256;
  launch_phase<0>(P, grid, stream); launch_phase<1>(P, grid, stream); launch_phase<2>(P, grid, stream); launch_phase<3>(P, grid, stream);
  launch_phase<4>(P, grid, stream); launch_phase<5>(P, grid, stream); launch_phase<6>(P, grid, stream); launch_phase<7>(P, grid, stream);
  launch_phase<8>(P, grid, stream); launch_phase<9>(P, grid, stream);
#endif
}
```

```cpp
#include <hip/hip_runtime.h>
#include <hip/hip_cooperative_groups.h>
#include <cstdio>
#include <cstdint>
#include <cstddef>
namespace cg = cooperative_groups;

#ifndef PROBE_MODE
#define PROBE_MODE 0
#endif
#ifndef ONE_LAUNCH
#define ONE_LAUNCH 1
#endif

#define DI __device__ __forceinline__
typedef unsigned short bf16_t;
typedef __attribute__((ext_vector_type(8))) short bf16x8;
typedef __attribute__((ext_vector_type(4))) short s16x4;
typedef __attribute__((ext_vector_type(4))) float f32x4;
typedef __attribute__((ext_vector_type(16))) float f32x16;
typedef __attribute__((ext_vector_type(4))) unsigned u32x4;
typedef __attribute__((ext_vector_type(2))) unsigned u32x2;

constexpr int DM = 1024, MTOK = 81920, MPROMPT = 65536, TP = 8192, TS = 2048;
constexpr int NIN = 3072;
constexpr int WIN_LD = 3088;
constexpr int DFF = 4096;
constexpr float EPS = 1e-6f;

constexpr size_t OFF_WT_IN = 0, OFF_WT_OUT = 6291456, OFF_WT_UP = 8388608, OFF_WT_DOWN = 16777216, OFF_GATES = 25165824,
                 OFF_CTR = 30408704, OFF_H = 31457280, OFF_P = 199229440, OFF_QKVC = 702545920, OFF_X1B = 870318080, OFF_KVC = 954204160, WS_END = 1038090240;

struct Params {
  const float *xp, *xs, *nmp, *w_in, *conv_w, *Alf, *Alb, *dtf, *dtb, *gnw, *qnw, *knw, *w_out, *nmpost, *nmlp, *w_up, *w_down, *nmlppost;
  float* out;
  bf16_t *wt_in, *wt_out, *wt_up, *wt_down;
  float* gates; float* rs2; float* rs1;
  bf16_t *h, *p, *qkvc, *of, *ob, *mix, *hm, *f, *f2, *x1b, *kvc, *mixed;
  unsigned* ctr;
};

constexpr int LDS_BYTES = 163840;
constexpr size_t PSEG_Z = (size_t)81920 * 1536, PSEG_Q = (size_t)81920 * 2048;

typedef __attribute__((ext_vector_type(2))) float f32x2;
typedef __attribute__((ext_vector_type(2))) __bf16 bf16x2_t;
DI unsigned cvtpk(float lo, float hi) { const f32x2 v = {lo, hi}; const bf16x2_t b = __builtin_convertvector(v, bf16x2_t); return __builtin_bit_cast(unsigned, b); }
DI float bflo(unsigned u) { return __uint_as_float(u << 16); }
DI float bfhi(unsigned u) { return __uint_as_float(u & 0xffff0000u); }
DI float bf2f(bf16_t b) { return __uint_as_float((unsigned)b << 16); }
DI bf16_t f2bf(float x) { return (bf16_t)(cvtpk(x, x) & 0xffffu); }
DI float shx(float v, int m, int lane) { return __int_as_float(__builtin_amdgcn_ds_bpermute((lane ^ m) << 2, __float_as_int(v))); }
DI unsigned shxu(unsigned v, int m, int lane) { return (unsigned)__builtin_amdgcn_ds_bpermute((lane ^ m) << 2, (int)v); }
template <int CTRL> DI float dppf(float v) { return __int_as_float(__builtin_amdgcn_update_dpp(0, __float_as_int(v), CTRL, 0xf, 0xf, true)); }
DI float xsum_step(float v, int o) {
  switch (o) {
    case 1: return v + dppf<0xB1>(v);
    case 2: return v + dppf<0x4E>(v);
    case 4: return v + dppf<0x141>(v);
    case 8: return v + dppf<0x140>(v);
    case 16: { auto r = __builtin_amdgcn_permlane16_swap(__float_as_uint(v), __float_as_uint(v), false, false); return __uint_as_float(r[0]) + __uint_as_float(r[1]); }
    default: { auto r = __builtin_amdgcn_permlane32_swap(__float_as_uint(v), __float_as_uint(v), false, false); return __uint_as_float(r[0]) + __uint_as_float(r[1]); }
  }
}
DI float wave_sum(float v, int lane) {
  (void)lane;
#pragma unroll
  for (int o = 1; o <= 32; o <<= 1) v = xsum_step(v, o);
  return v;
}
DI float silu(float x) { return x / (1.f + __expf(-x)); }

constexpr int GBM = 256, GBN = 128, GBK = 64, G_A_BYTES = GBM * GBK * 2, G_B_BYTES = GBN * GBK * 2, G_STAGE = G_A_BYTES + G_B_BYTES;
DI int gswz(int row, int chunk) { return row * 128 + ((chunk ^ ((row >> 1) & 7)) << 4); }

template <class Epi>
DI void gemm_tile(const bf16_t* __restrict__ A, int lda, const bf16_t* __restrict__ Bt, int ldb, int K, int m0, int n0, char* lds, const Epi& epi, int tid_in) {
  const int tid = tid_in, wid = tid >> 6, lane = tid & 63, wm = wid >> 1, wn = wid & 1, fr = lane & 15, fq = lane >> 4;
  f32x4 acc[4][4];
#pragma unroll
  for (int a = 0; a < 4; ++a)
#pragma unroll
    for (int b = 0; b < 4; ++b) acc[a][b] = (f32x4){0.f, 0.f, 0.f, 0.f};
  const bf16_t* Ag = A + (size_t)m0 * lda;
  const bf16_t* Bg = Bt + (size_t)n0 * ldb;
  const int srow = tid >> 3, sc = tid & 7;
  u32x4 ra[4], rb[2];
#define G_LOAD(k0) do { _Pragma("unroll") for (int i = 0; i < 4; ++i) ra[i] = *(const u32x4*)(Ag + (size_t)(srow + 64 * i) * lda + (k0) + sc * 8); \
                        _Pragma("unroll") for (int i = 0; i < 2; ++i) rb[i] = *(const u32x4*)(Bg + (size_t)(srow + 64 * i) * ldb + (k0) + sc * 8); } while (0)
#define G_STORE(st) do { _Pragma("unroll") for (int i = 0; i < 4; ++i) *(u32x4*)((st) + gswz(srow + 64 * i, sc)) = ra[i]; \
                         _Pragma("unroll") for (int i = 0; i < 2; ++i) *(u32x4*)((st) + G_A_BYTES + gswz(srow + 64 * i, sc)) = rb[i]; } while (0)
  G_LOAD(0); G_STORE(lds); __syncthreads();
  const int nk = K / GBK;
  for (int kt = 0; kt < nk; ++kt) {
    char* cur = lds + (kt & 1) * G_STAGE;
    char* nxt = lds + ((kt + 1) & 1) * G_STAGE;
    if (kt + 1 < nk) G_LOAD((kt + 1) * GBK);
#pragma unroll
    for (int ks = 0; ks < 2; ++ks) {
      bf16x8 af[4], bfr[4];
#pragma unroll
      for (int mi = 0; mi < 4; ++mi) af[mi] = *(const bf16x8*)(cur + gswz(wm * 64 + mi * 16 + fr, ks * 4 + fq));
#pragma unroll
      for (int ni = 0; ni < 4; ++ni) bfr[ni] = *(const bf16x8*)(cur + G_A_BYTES + gswz(wn * 64 + ni * 16 + fr, ks * 4 + fq));
#pragma unroll
      for (int mi = 0; mi < 4; ++mi)
#pragma unroll
        for (int ni = 0; ni < 4; ++ni) acc[mi][ni] = __builtin_amdgcn_mfma_f32_16x16x32_bf16(bfr[ni], af[mi], acc[mi][ni], 0, 0, 0);
    }
    if (kt + 1 < nk) G_STORE(nxt);
    __syncthreads();
  }
#undef G_LOAD
#undef G_STORE
#pragma unroll
  for (int mi = 0; mi < 4; ++mi)
#pragma unroll
    for (int ni = 0; ni < 4; ++ni) epi(m0 + wm * 64 + mi * 16 + fr, n0 + wn * 64 + ni * 16 + fq * 4, acc[mi][ni]);
}

struct EpiBf16 {
  bf16_t* O; int ldo;
  DI void operator()(int m, int n, f32x4 v) const { u32x2 w; w.x = cvtpk(v[0], v[1]); w.y = cvtpk(v[2], v[3]); *(u32x2*)(O + (size_t)m * ldo + n) = w; }
};
struct EpiRelu2 {
  bf16_t* O; int ldo;
  DI void operator()(int m, int n, f32x4 v) const {
    float a = fmaxf(v[0], 0.f), b = fmaxf(v[1], 0.f), c = fmaxf(v[2], 0.f), d = fmaxf(v[3], 0.f);
    u32x2 w; w.x = cvtpk(a * a, b * b); w.y = cvtpk(c * c, d * d); *(u32x2*)(O + (size_t)m * ldo + n) = w; }
};

template <class Epi>
DI void gemm_phase(const bf16_t* A, int lda, const bf16_t* Bt, int K, int N, char* lds, const Epi& epi, int tid_in) {
  const int ntn = N / GBN, ntiles = (MTOK / GBM) * ntn;
  for (int t = blockIdx.x; t < ntiles; t += gridDim.x) {
    const int mt = t / ntn, nt = t % ntn;
    gemm_tile(A, lda, Bt, K, K, mt * GBM, nt * GBN, lds, epi, tid_in);
  }
}


namespace pg8 {
#define PG8_LAS __attribute__((address_space(3)))
constexpr int BM = 256, BK = 64, HALF = 128, HTB = HALF * BK * 2, STAGE_BYTES = 8 * HTB, NXCD = 8, WGM = 8;
__host__ __device__ __forceinline__ int lds_byte(int r, int c) { const int st = (r >> 4) * 2 + (c >> 5), rr = r & 15, cc = c & 31, ob = rr * 64 + cc * 2; return st * 1024 + (ob ^ (((ob >> 9) & 1) << 5)); }
__host__ __device__ __forceinline__ void stage_rc(int b, int& R, int& C) { const int st = b / 1024, sb = b % 1024, swz = sb ^ (((sb >> 9) & 1) << 5); R = (st >> 1) * 16 + swz / 64; C = (st & 1) * 32 + (swz % 64) / 2; }
__host__ __device__ __forceinline__ int perm32(int rho) { const int n = rho >> 4, i = rho & 15; return 8 * (i >> 2) + 4 * n + (i & 3); }
struct Unit { int pm, pn; };
struct Gemm { const bf16_t* A; const bf16_t* Bt; int M, N, K, lda; };
struct StaticOrder {
    int nM, nN, nwg, G, c;
    __host__ __device__ void init(int M, int N, int G_, int c_) { nM = M / BM; nN = N / BM; nwg = nM * nN; G = G_; c = c_; }
    __host__ __device__ bool next(int i, Unit& u) const {
        const long L = (long)i * G + c; if (L >= nwg) return false;
        int wgid = (int)L; { const int q = nwg / NXCD, r = nwg % NXCD, xcd = wgid % NXCD, off = wgid / NXCD; wgid = (xcd < r ? xcd * (q + 1) : r * (q + 1) + (xcd - r) * q) + off; }
        const int nig = WGM * nN, gid = wgid / nig, fm = gid * WGM, gsz = (nM - fm) < WGM ? (nM - fm) : WGM;
        u.pm = fm + ((wgid % nig) % gsz); u.pn = (wgid % nig) / gsz; return true;
    }
    __device__ __forceinline__ void a_ready(const Unit&) const {}
    __device__ __forceinline__ void done(const Unit&) const {}
};
template <int ACT  , bool SCALE  > struct EpiStore {
    static constexpr bool PERM = true, AFTER_DRAIN = false;
    bf16_t* O; int ldc;
    const float* rowsc;
    bf16_t* kv;
    __device__ __forceinline__ void operator()(const f32x4 (&acc)[2][2][4][2], const Unit& u, int wr, int wc, int fr, int fq) const {
        const int row0 = u.pm * BM + wr * 64 + fr, col0 = u.pn * BM + wc * 32 + 8 * fq;
        if (kv != nullptr && u.pn >= 10) {
            bf16_t* base = kv + (size_t)(u.pn - 10) * 2 * MTOK * 128 + wc * 32 + 8 * fq;
#pragma unroll
            for (int ai = 0; ai < 2; ++ai)
#pragma unroll
                for (int m = 0; m < 4; ++m) { const float rsl = SCALE ? rowsc[row0 + ai * HALF + m * 16] : 1.f;
#pragma unroll
                    for (int bj = 0; bj < 2; ++bj) {
                        const f32x4 v0 = acc[ai][bj][m][0] * rsl, v1 = acc[ai][bj][m][1] * rsl;
                        u32x4 w; w.x = cvtpk(v0[0], v0[1]); w.y = cvtpk(v0[2], v0[3]); w.z = cvtpk(v1[0], v1[1]); w.w = cvtpk(v1[2], v1[3]);
                        *(u32x4*)(base + ((size_t)bj * MTOK + (row0 + ai * HALF + m * 16)) * 128) = w; } }
            return;
        }
        bf16_t* Oseg = O; int ldseg = ldc, cseg = col0;
        if (kv != nullptr) { if (u.pn < 6) { ldseg = 1536; } else if (u.pn < 8) { Oseg = O + PSEG_Z; ldseg = 512; cseg = col0 - 1536; } else { Oseg = O + PSEG_Q; ldseg = 512; cseg = col0 - 2048; } }
#pragma unroll
        for (int ai = 0; ai < 2; ++ai)
#pragma unroll
            for (int m = 0; m < 4; ++m) { bf16_t* rowp = Oseg + (size_t)(row0 + ai * HALF + m * 16) * ldseg + cseg;
                float rs2 = 1.f; if (SCALE) { const float rs = rowsc[row0 + ai * HALF + m * 16]; rs2 = ACT == 1 ? rs * rs : rs; }
#pragma unroll
                for (int bj = 0; bj < 2; ++bj) { f32x4 v0 = acc[ai][bj][m][0], v1 = acc[ai][bj][m][1];
                    if (ACT == 1) {
#pragma unroll
                        for (int e = 0; e < 4; ++e) { const float a = fmaxf(v0[e], 0.f), b = fmaxf(v1[e], 0.f); v0[e] = a * a * rs2; v1[e] = b * b * rs2; } }
                    else if (SCALE) { v0 = v0 * rs2; v1 = v1 * rs2; }
                    u32x4 w; w.x = cvtpk(v0[0], v0[1]); w.y = cvtpk(v0[2], v0[3]); w.z = cvtpk(v1[0], v1[1]); w.w = cvtpk(v1[2], v1[3]);
                    *(u32x4*)(rowp + bj * HALF) = w; } }
    }
};
template <class Epi, class Sched, bool ALIGN_EPI = false, bool SP2 = false>
__device__ __forceinline__ void gemm_phase(PG8_LAS unsigned char* lds, const Gemm g, const Sched& S, const Epi& E, int tid_in) {
    const int tid = tid_in, wid = __builtin_amdgcn_readfirstlane(tid >> 6), lane = tid & 63, wr = wid >> 2, wc = wid & 3, fr = lane & 15, fq = lane >> 4;
    const int K = g.K, nt = K / BK;
    unsigned voffA[2], voffB[2];
#pragma unroll
    for (int i = 0; i < 2; ++i) { int R, C; stage_rc(tid * 16 + i * 8192, R, C); const int Rb = Epi::PERM ? ((R & ~31) + perm32(R & 31)) : R;
        voffA[i] = (unsigned)(R * g.lda + C) * 2u; voffB[i] = (unsigned)(Rb * K + C) * 2u; }
    const size_t kstep = (size_t)(BK * 2);
    const size_t hstepB = (size_t)HALF * K * 2, hstepA = (size_t)HALF * g.lda * 2;
    const size_t tstepB = 2 * hstepB, tstepA = 2 * hstepA;
    const unsigned ldsw = (unsigned)wid * 1024u;
    const int aoff = lds_byte(wr * 64 + fr, fq * 8), boff = lds_byte(wc * 32 + fr, fq * 8);
#define PG8_SA(b, h) (((b) * 2 + (h)) * HTB)
#define PG8_SB(b, h) ((4 + (b) * 2 + (h)) * HTB)
#define PG8_STAGE(bufoff, gbase, voff) do { _Pragma("unroll") for (int _i = 0; _i < 2; ++_i) \
        __builtin_amdgcn_global_load_lds((const unsigned*)((const char*)(gbase) + (voff)[_i]), (PG8_LAS unsigned*)(lds + (bufoff) + ldsw + _i * 8192), 16, 0, 0); } while (0)
#define PG8_LDA(dst, b, h) do { _Pragma("unroll") for (int m = 0; m < 4; ++m) _Pragma("unroll") for (int k = 0; k < 2; ++k) dst[m][k] = *(const PG8_LAS bf16x8*)(lds + PG8_SA(b, h) + aoff + m * 2048 + k * 1024); } while (0)
#define PG8_LDB(dst, b, h) do { _Pragma("unroll") for (int n = 0; n < 2; ++n) _Pragma("unroll") for (int k = 0; k < 2; ++k) dst[n][k] = *(const PG8_LAS bf16x8*)(lds + PG8_SB(b, h) + boff + n * 2048 + k * 1024); } while (0)
#define PG8_MMA(ai, bj, At, Bt) do { __builtin_amdgcn_s_setprio(1); _Pragma("unroll") for (int m = 0; m < 4; ++m) _Pragma("unroll") for (int n = 0; n < 2; ++n) _Pragma("unroll") for (int k = 0; k < 2; ++k) \
        acc[ai][bj][m][n] = __builtin_amdgcn_mfma_f32_16x16x32_bf16(Bt[n][k], At[m][k], acc[ai][bj][m][n], 0, 0, 0); __builtin_amdgcn_s_setprio(0); } while (0)
#define PG8_WAIT_V(n) asm volatile("s_waitcnt vmcnt(" #n ")" ::: "memory")
#define PG8_WAIT_L(n) asm volatile("s_waitcnt lgkmcnt(" #n ")" ::: "memory")
#define PG8_BAR __builtin_amdgcn_s_barrier()
#define PG8_SCHED __builtin_amdgcn_sched_barrier(0)
    Unit cur, nxt; int ui = 0;
    if (!S.next(0, cur)) return;
    f32x4 acc[2][2][4][2];
#pragma unroll
    for (int a = 0; a < 2; ++a)
#pragma unroll
        for (int b = 0; b < 2; ++b)
#pragma unroll
            for (int m = 0; m < 4; ++m)
#pragma unroll
                for (int n = 0; n < 2; ++n) acc[a][b][m][n] = (f32x4){0.f, 0.f, 0.f, 0.f};
    bf16x8 At[4][2], B0[2][2], B1[2][2];
    const char* cA = (const char*)g.A + (size_t)cur.pm * tstepA; const char* cB = (const char*)g.Bt + (size_t)cur.pn * tstepB;
    S.a_ready(cur);
    if constexpr (SP2) {
        PG8_STAGE(PG8_SB(0, 0), cB, voffB); PG8_STAGE(PG8_SB(0, 1), cB + hstepB, voffB); PG8_STAGE(PG8_SA(0, 0), cA, voffA); PG8_STAGE(PG8_SA(0, 1), cA + hstepA, voffA);
        if (wr == 1) PG8_BAR;
        PG8_WAIT_V(2); PG8_BAR;
        PG8_STAGE(PG8_SB(1, 0), cB + kstep, voffB); PG8_STAGE(PG8_SA(1, 0), cA + kstep, voffA); PG8_STAGE(PG8_SB(1, 1), cB + hstepB + kstep, voffB);
        PG8_WAIT_V(6); PG8_BAR;
    } else {
        PG8_STAGE(PG8_SB(0, 0), cB, voffB); PG8_STAGE(PG8_SA(0, 0), cA, voffA); PG8_STAGE(PG8_SB(0, 1), cB + hstepB, voffB); PG8_STAGE(PG8_SA(0, 1), cA + hstepA, voffA);
        if (wr == 1) PG8_BAR;
        PG8_WAIT_V(4); PG8_BAR;
        PG8_STAGE(PG8_SB(1, 0), cB + kstep, voffB); PG8_STAGE(PG8_SA(1, 0), cA + kstep, voffA); PG8_STAGE(PG8_SB(1, 1), cB + hstepB + kstep, voffB);
        PG8_WAIT_V(6); PG8_BAR;
    }
    for (;;) {
        const bool has_next = S.next(ui + 1, nxt);
        const char* nA = has_next ? (const char*)g.A + (size_t)nxt.pm * tstepA : cA; const char* nB = has_next ? (const char*)g.Bt + (size_t)nxt.pn * tstepB : cB;
        for (int t = 0; t < nt; t += 2) {
            const bool last = (t == nt - 2);
            const char* a1 = cA + (size_t)(t + 1) * kstep;
            const char* a2 = last ? nA : cA + (size_t)(t + 2) * kstep; const char* b2 = last ? nB : cB + (size_t)(t + 2) * kstep;
            const char* a3 = a2 + kstep; const char* b3 = b2 + kstep;
            if (last && has_next) S.a_ready(nxt);
            if constexpr (SP2) {
            PG8_LDB(B0, 0, 0); PG8_LDB(B1, 0, 1); PG8_SCHED; PG8_LDA(At, 0, 0); PG8_STAGE(PG8_SA(1, 1), a1 + hstepA, voffA);
            PG8_WAIT_V(8); PG8_WAIT_L(0); PG8_BAR; PG8_MMA(0, 0, At, B0); PG8_MMA(0, 1, At, B1); PG8_BAR; PG8_SCHED;
            PG8_LDA(At, 0, 1); PG8_STAGE(PG8_SB(0, 0), b2, voffB); PG8_STAGE(PG8_SB(0, 1), b2 + hstepB, voffB); PG8_STAGE(PG8_SA(0, 0), a2, voffA);
            PG8_WAIT_V(8); PG8_WAIT_L(0); PG8_BAR; PG8_MMA(1, 0, At, B0); PG8_MMA(1, 1, At, B1); PG8_BAR; PG8_SCHED;
            PG8_LDB(B0, 1, 0); PG8_LDB(B1, 1, 1); PG8_SCHED; PG8_LDA(At, 1, 0); PG8_STAGE(PG8_SA(0, 1), a2 + hstepA, voffA);
            PG8_WAIT_V(8); PG8_WAIT_L(0); PG8_BAR; PG8_MMA(0, 0, At, B0); PG8_MMA(0, 1, At, B1); PG8_BAR; PG8_SCHED;
            PG8_LDA(At, 1, 1); PG8_STAGE(PG8_SB(1, 0), b3, voffB); PG8_STAGE(PG8_SB(1, 1), b3 + hstepB, voffB); PG8_STAGE(PG8_SA(1, 0), a3, voffA);
            PG8_WAIT_V(8); PG8_WAIT_L(0); PG8_BAR; PG8_MMA(1, 0, At, B0); PG8_MMA(1, 1, At, B1); PG8_BAR; PG8_SCHED;
            } else {
            PG8_LDB(B0, 0, 0); PG8_SCHED; PG8_LDA(At, 0, 0); PG8_STAGE(PG8_SA(1, 1), a1 + hstepA, voffA);
            PG8_WAIT_L(8); PG8_BAR; PG8_WAIT_L(0); PG8_MMA(0, 0, At, B0); PG8_BAR; PG8_SCHED;
            PG8_LDB(B1, 0, 1); PG8_STAGE(PG8_SB(0, 0), b2, voffB);
            PG8_BAR; PG8_WAIT_L(0); PG8_MMA(0, 1, At, B1); PG8_BAR;
            PG8_LDA(At, 0, 1); PG8_STAGE(PG8_SA(0, 0), a2, voffA);
            PG8_BAR; PG8_WAIT_L(0); PG8_MMA(1, 0, At, B0); PG8_BAR; PG8_SCHED;
            PG8_STAGE(PG8_SB(0, 1), b2 + hstepB, voffB);
            PG8_WAIT_V(6); PG8_BAR; PG8_MMA(1, 1, At, B1); PG8_BAR;
            PG8_LDB(B0, 1, 0); PG8_SCHED; PG8_LDA(At, 1, 0); PG8_STAGE(PG8_SA(0, 1), a2 + hstepA, voffA);
            PG8_WAIT_L(8); PG8_BAR; PG8_WAIT_L(0); PG8_MMA(0, 0, At, B0); PG8_BAR; PG8_SCHED;
            PG8_LDB(B1, 1, 1); PG8_STAGE(PG8_SB(1, 0), b3, voffB);
            PG8_BAR; PG8_WAIT_L(0); PG8_MMA(0, 1, At, B1); PG8_BAR;
            PG8_LDA(At, 1, 1); PG8_STAGE(PG8_SA(1, 0), a3, voffA);
            PG8_BAR; PG8_WAIT_L(0); PG8_MMA(1, 0, At, B0); PG8_BAR; PG8_SCHED;
            PG8_STAGE(PG8_SB(1, 1), b3 + hstepB, voffB);
            PG8_WAIT_V(6); PG8_BAR; PG8_MMA(1, 1, At, B1); PG8_BAR;
            }
        }
        if constexpr (ALIGN_EPI) { if (wr == 0) PG8_BAR; }
        if constexpr (!Epi::AFTER_DRAIN) { E(acc, cur, wr, wc, fr, fq); S.done(cur); }
        if (!has_next) break;
#pragma unroll
        for (int a = 0; a < 2; ++a)
#pragma unroll
            for (int b = 0; b < 2; ++b)
#pragma unroll
                for (int m = 0; m < 4; ++m)
#pragma unroll
                    for (int n = 0; n < 2; ++n) acc[a][b][m][n] = (f32x4){0.f, 0.f, 0.f, 0.f};
        cur = nxt; cA = nA; cB = nB; ++ui;
        if constexpr (ALIGN_EPI) { if (wr == 1) PG8_BAR; }
    }
    PG8_WAIT_V(0);
    if constexpr (!ALIGN_EPI) { if (wr == 0) PG8_BAR; }
    PG8_BAR;
    if constexpr (Epi::AFTER_DRAIN) { E.fused(acc, cur, wr, wc, fr, fq, lds, wid, lane); S.done(cur); }
#undef PG8_SA
#undef PG8_SB
#undef PG8_STAGE
#undef PG8_LDA
#undef PG8_LDB
#undef PG8_MMA
#undef PG8_WAIT_V
#undef PG8_WAIT_L
#undef PG8_BAR
#undef PG8_SCHED
}
}
template <int ACT, bool SCALE = false> DI void gemm8(const bf16_t* A, int lda, const bf16_t* Bt, int K, int N, bf16_t* O, int ldc, char* lds, int tid_in, bf16_t* kv = nullptr, const float* rowsc = nullptr) {
  pg8::Gemm g{A, Bt, MTOK, N, K, lda};
  pg8::StaticOrder S; S.init(MTOK, N, (int)gridDim.x, (int)blockIdx.x);
  pg8::EpiStore<ACT, SCALE> E{O, ldc, rowsc, kv};
  pg8::gemm_phase<pg8::EpiStore<ACT, SCALE>, pg8::StaticOrder, true, true>((PG8_LAS unsigned char*)lds, g, S, E, tid_in);
}

DI void transpose_tile(const float* __restrict__ W, int ldw, int ncol0, bf16_t* __restrict__ Wt, int K, int k0, int n0, float* tile, int lane, const float* ksc = nullptr) {
  const int r = lane >> 4, c4 = (lane & 15) * 4;
  f32x4 v[16];
#pragma unroll
  for (int i = 0; i < 16; ++i) { v[i] = *(const f32x4*)(W + (size_t)(k0 + r + 4 * i) * ldw + ncol0 + c4); if (ksc != nullptr) v[i] = v[i] * ksc[k0 + r + 4 * i]; }
#pragma unroll
  for (int i = 0; i < 16; ++i) *(f32x4*)(tile + (r + 4 * i) * 68 + c4) = v[i];
#pragma unroll
  for (int kc = 0; kc < 8; ++kc) {
    float x[8];
#pragma unroll
    for (int j = 0; j < 8; ++j) x[j] = tile[(kc * 8 + j) * 68 + lane];
    u32x4 w; w.x = cvtpk(x[0], x[1]); w.y = cvtpk(x[2], x[3]); w.z = cvtpk(x[4], x[5]); w.w = cvtpk(x[6], x[7]);
    *(u32x4*)(Wt + (size_t)(n0 + lane) * K + k0 + kc * 8) = w;
  }
}

DI void phase0(const Params& P, char* lds, int tid_in) {
  const int tid = tid_in, wid = tid >> 6, lane = tid & 63;
  float* tile = (float*)lds + wid * (64 * 68);
  if (blockIdx.x == 0 && tid == 0) *P.ctr = 0u;
  for (int t = blockIdx.x * 8 + wid; t < 3072; t += gridDim.x * 8) {
    if (t < 768) { const int kt = t / 48, nt = t % 48, n0 = nt * 64; transpose_tile(P.w_in, WIN_LD, n0 < 2048 ? n0 : n0 + 16, P.wt_in, 1024, kt * 64, n0, tile, lane, P.nmp); }
    else if (t < 1024) { const int u = t - 768, kt = u / 16, nt = u % 16; transpose_tile(P.w_out, 1024, nt * 64, P.wt_out, 1024, kt * 64, nt * 64, tile, lane); }
    else if (t < 2048) { const int u = t - 1024, kt = u / 64, nt = u % 64; transpose_tile(P.w_up, 4096, nt * 64, P.wt_up, 1024, kt * 64, nt * 64, tile, lane, P.nmlp); }
    else { const int u = t - 2048, kt = u / 16, nt = u % 16; transpose_tile(P.w_down, 1024, nt * 64, P.wt_down, 4096, kt * 64, nt * 64, tile, lane); }
  }
  __syncthreads();
  float* Wg = (float*)lds;
  for (int i = tid; i < 1024 * 16; i += 512) { const int k = i >> 4, c = i & 15; Wg[c * 1024 + k] = P.w_in[(size_t)k * WIN_LD + 2048 + c] * P.nmp[k]; }
  __syncthreads();
  f32x4 nw[4];
#pragma unroll
  for (int j = 0; j < 4; ++j) nw[j] = *(const f32x4*)(P.nmp + j * 256 + lane * 4);
  const int nwaves = gridDim.x * 8;
#pragma unroll 1
  for (int m = (blockIdx.x * 8 + wid) * 2; m < MTOK; m += nwaves * 2) {
    const float* xr = m < MPROMPT ? P.xp + (size_t)m * DM : P.xs + (size_t)(m - MPROMPT) * DM;
    f32x4 x0[4], x1[4]; float ss0 = 0.f, ss1 = 0.f;
#pragma unroll
    for (int j = 0; j < 4; ++j) { x0[j] = __builtin_nontemporal_load((const f32x4*)(xr + j * 256 + lane * 4)); x1[j] = __builtin_nontemporal_load((const f32x4*)(xr + DM + j * 256 + lane * 4)); }
#pragma unroll
    for (int j = 0; j < 4; ++j) { ss0 += x0[j][0] * x0[j][0] + x0[j][1] * x0[j][1] + x0[j][2] * x0[j][2] + x0[j][3] * x0[j][3];
                                  ss1 += x1[j][0] * x1[j][0] + x1[j][1] * x1[j][1] + x1[j][2] * x1[j][2] + x1[j][3] * x1[j][3]; }
    float g0[16], g1[16];
#pragma unroll
    for (int c = 0; c < 16; ++c) { g0[c] = 0.f; g1[c] = 0.f; }
#pragma unroll
    for (int c = 0; c < 16; ++c) {
#pragma unroll
      for (int j = 0; j < 4; ++j) {
        const f32x4 w = *(const f32x4*)(Wg + c * 1024 + j * 256 + lane * 4);
        g0[c] += x0[j][0] * w[0] + x0[j][1] * w[1] + x0[j][2] * w[2] + x0[j][3] * w[3];
        g1[c] += x1[j][0] * w[0] + x1[j][1] * w[1] + x1[j][2] * w[2] + x1[j][3] * w[3];
      }
      if ((c & 3) == 3) asm volatile("" ::: "memory");
    }
    ss0 = wave_sum(ss0, lane); ss1 = wave_sum(ss1, lane);
    const float rs0 = rsqrtf(ss0 * (1.f / DM) + EPS), rs1 = rsqrtf(ss1 * (1.f / DM) + EPS);
    asm volatile("" ::: "memory");
#pragma unroll
    for (int j = 0; j < 4; ++j) {
      const f32x4 h0 = x0[j], h1 = x1[j];
      u32x2 a, b2; a.x = cvtpk(h0[0], h0[1]); a.y = cvtpk(h0[2], h0[3]); b2.x = cvtpk(h1[0], h1[1]); b2.y = cvtpk(h1[2], h1[3]);
      *(u32x2*)(P.h + (size_t)m * DM + j * 256 + lane * 4) = a; *(u32x2*)(P.h + (size_t)(m + 1) * DM + j * 256 + lane * 4) = b2;
    }
#define HALVE(G, N, MASK) do { const bool up_ = (lane & (MASK)) != 0; _Pragma("unroll") for (int k_ = 0; k_ < (N); ++k_) { \
      const float send_ = up_ ? G[k_] : G[k_ + (N)], keep_ = up_ ? G[k_ + (N)] : G[k_]; G[k_] = keep_ + shx(send_, (MASK), lane); } } while (0)
    HALVE(g0, 8, 32); HALVE(g1, 8, 32); HALVE(g0, 4, 16); HALVE(g1, 4, 16); HALVE(g0, 2, 8); HALVE(g1, 2, 8); HALVE(g0, 1, 4); HALVE(g1, 1, 4);
#undef HALVE
    float v0 = g0[0], v1 = g1[0];
    v0 += shx(v0, 2, lane); v1 += shx(v1, 2, lane); v0 += shx(v0, 1, lane); v1 += shx(v1, 1, lane);
    const int cc = ((lane >> 5) & 1) * 8 + ((lane >> 4) & 1) * 4 + ((lane >> 3) & 1) * 2 + ((lane >> 2) & 1);
    if ((lane & 3) < 2) {
      const int rsel = lane & 3;
      const float v = rsel == 0 ? v0 * rs0 : v1 * rs1;
      float r;
      if (cc < 8) r = 1.f / (1.f + __expf(-v));
      else {
        const int dir = (cc - 8) >> 2, hh = cc & 3;
        const float Al = dir ? P.Alb[hh] : P.Alf[hh], db = dir ? P.dtb[hh] : P.dtf[hh];
        const float z = v + db;
        const float sp = z > 20.f ? z : log1pf(expf(z));
        r = -expf(Al) * sp;
      }
      P.gates[(size_t)(m + rsel) * 16 + cc] = r;
      if (lane < 2) P.rs1[m + rsel] = rsel == 0 ? rs0 : rs1;
    }
  }
}

DI void phase2(const Params& P, int tid_in) {
  const int tid = tid_in, wid = tid >> 6, lane = tid & 63;
  const int nwaves = gridDim.x * 8;
  constexpr int TB = 16;
  for (int item = blockIdx.x * 8 + wid; item < 1280 * 9; item += nwaves) {
    const int ci = item / 9, it = item % 9;
    const long m0 = (long)ci * 64;
    long sb, se;
    if (m0 < MPROMPT) { sb = (m0 / TP) * TP; se = sb + TP; } else { sb = MPROMPT + ((m0 - MPROMPT) / TS) * TS; se = sb + TS; }
    if (it < 6) {
      const int ghv = 2 * it + (lane >> 5), c4 = (lane & 31) * 4, col = ghv * 128 + c4;
      float w[5][4];
#pragma unroll
      for (int j = 0; j < 5; ++j) { const f32x4 wv = *(const f32x4*)(P.conv_w + j * 1536 + col); w[j][0] = wv[0]; w[j][1] = wv[1]; w[j][2] = wv[2]; w[j][3] = wv[3]; }
      u32x2 buf[TB + 4];
#pragma unroll
      for (int j = 0; j < 4; ++j) { const long r = m0 - 2 + j; buf[j] = (r >= sb && r < se) ? *(const u32x2*)(P.p + (size_t)r * 1536 + col) : (u32x2){0u, 0u}; }
      bf16_t* const obase = P.qkvc + ((size_t)(ghv & 3) * MTOK) * 384 + (ghv >> 2) * 128 + c4;
      for (int t0 = 0; t0 < 64; t0 += TB) {
#pragma unroll
        for (int j = 0; j < TB; ++j) { const long r = m0 + t0 + 2 + j; buf[4 + j] = (r >= sb && r < se) ? *(const u32x2*)(P.p + (size_t)r * 1536 + col) : (u32x2){0u, 0u}; }
        float av[TB][4];
#pragma unroll
        for (int t = 0; t < TB; ++t) {
          float x0 = 0.f, x1 = 0.f, x2 = 0.f, x3 = 0.f;
#pragma unroll
          for (int j = 0; j < 5; ++j) { x0 += bflo(buf[t + j].x) * w[j][0]; x1 += bfhi(buf[t + j].x) * w[j][1]; x2 += bflo(buf[t + j].y) * w[j][2]; x3 += bfhi(buf[t + j].y) * w[j][3]; }
          av[t][0] = silu(x0); av[t][1] = silu(x1); av[t][2] = silu(x2); av[t][3] = silu(x3);
        }
        if (it < 4) {
          float ss[TB];
#pragma unroll
          for (int t = 0; t < TB; ++t) ss[t] = (av[t][0] * av[t][0] + av[t][1] * av[t][1]) + (av[t][2] * av[t][2] + av[t][3] * av[t][3]);
#pragma unroll
          for (int o = 1; o <= 16; o <<= 1)
#pragma unroll
            for (int t = 0; t < TB; ++t) ss[t] = xsum_step(ss[t], o);
          const float hs = it < 2 ? 0.08838834764831845f : 1.f;
#pragma unroll
          for (int t = 0; t < TB; ++t) { const float sc = rsqrtf(ss[t] + EPS) * hs; av[t][0] *= sc; av[t][1] *= sc; av[t][2] *= sc; av[t][3] *= sc; }
        }
#pragma unroll
        for (int t = 0; t < TB; ++t) { u32x2 wv; wv.x = cvtpk(av[t][0], av[t][1]); wv.y = cvtpk(av[t][2], av[t][3]); *(u32x2*)(obase + (size_t)(m0 + t0 + t) * 384) = wv; }
#pragma unroll
        for (int j = 0; j < 4; ++j) buf[j] = buf[TB + j];
      }
    } else {
      const int l32 = lane & 31, c4 = l32 * 4, ah = 2 * (it - 6) + (lane >> 5);
      constexpr int TBA = 16;
      bf16_t* const rbase = ah < 4 ? P.p + PSEG_Q + ah * 128 + c4 : P.kvc + (size_t)(ah - 4) * MTOK * 128 + c4;
      const size_t rstride = ah < 4 ? (size_t)512 : (size_t)128;
      const f32x4 nw = *(const f32x4*)((ah < 4 ? P.qnw : P.knw) + c4);
      float ifr[4];
#pragma unroll
      for (int e = 0; e < 4; ++e) ifr[e] = exp2f(-(float)(4 * (l32 & 7) + e) * (13.287712379549449f / 32.f));
      const float rowpos = (float)((m0 - sb) >> 6);
      const bool isx2 = (l32 & 8) != 0, iscol = l32 >= 16;
      for (int t0 = 0; t0 < 64; t0 += TBA) {
        u32x2 u[TBA]; float xv[TBA][4], ss[TBA];
#pragma unroll
        for (int t = 0; t < TBA; ++t) u[t] = *(const u32x2*)(rbase + (size_t)(m0 + t0 + t) * rstride);
#pragma unroll
        for (int t = 0; t < TBA; ++t) { xv[t][0] = bflo(u[t].x); xv[t][1] = bfhi(u[t].x); xv[t][2] = bflo(u[t].y); xv[t][3] = bfhi(u[t].y);
          ss[t] = (xv[t][0] * xv[t][0] + xv[t][1] * xv[t][1]) + (xv[t][2] * xv[t][2] + xv[t][3] * xv[t][3]); }
#pragma unroll
        for (int o = 1; o <= 16; o <<= 1)
#pragma unroll
          for (int t = 0; t < TBA; ++t) ss[t] = xsum_step(ss[t], o);
#pragma unroll
        for (int t = 0; t < TBA; ++t) {
          const float rs = rsqrtf(ss[t] * (1.f / 128.f) + EPS);
          const float pos = iscol ? (float)(t0 + t) : rowpos;
          float ov[4];
#pragma unroll
          for (int e = 0; e < 4; ++e) {
            const float x = xv[t][e] * rs * nw[e];
            const float an = pos * ifr[e], cs = __cosf(an), sn = __sinf(an);
            const float pr = dppf<0x128>(x);
            ov[e] = isx2 ? (pr * sn + x * cs) : (x * cs - pr * sn);
          }
          u32x2 w; w.x = cvtpk(ov[0], ov[1]); w.y = cvtpk(ov[2], ov[3]);
          *(u32x2*)(rbase + (size_t)(m0 + t0 + t) * rstride) = w;
        }
      }
    }
  }
}

constexpr int AD = 128, ANW = 8, AQBLK = 32, AKVBLK = 64, LDQ = 512, LDK = 128, LDO = DM;
constexpr float ASCALE = 0.088388347648318440f, ATHR = 8.f;
constexpr size_t SHM_V = AKVBLK * AD * 2, SHM_K = AKVBLK * AD * 2;
#define KSWZ(row, colB) ((row) * 256 + ((colB) ^ (((row) & 7) << 4)))
#define SBAR() __builtin_amdgcn_sched_barrier(0)
DI int crow(int r, int hi) { return (r & 3) + 8 * (r >> 2) + 4 * hi; }
DI void partialSM(f32x16& p0, f32x16& p1, float& m_reg, float& mn, float& alpha) {
  constexpr float C = ASCALE * 1.4426950408889634f;
  float pmax = p0[0];
#pragma unroll
  for (int r = 1; r < 16; ++r) pmax = fmaxf(pmax, p0[r]);
#pragma unroll
  for (int r = 0; r < 16; ++r) pmax = fmaxf(pmax, p1[r]);
  { auto rr = __builtin_amdgcn_permlane32_swap(__float_as_uint(pmax), __float_as_uint(pmax), false, false);
    pmax = fmaxf(__uint_as_float(rr[0]), __uint_as_float(rr[1])); }
  if (__builtin_expect(__all(pmax - m_reg <= ATHR / ASCALE), 1)) { mn = m_reg; alpha = 1.f; }
  else { mn = fmaxf(m_reg, pmax); alpha = __builtin_amdgcn_exp2f((m_reg - mn) * C); m_reg = mn; }
  const float mnC = -mn * C;
#pragma unroll
  for (int r = 0; r < 16; ++r) p0[r] = fmaf(p0[r], C, mnC);
#pragma unroll
  for (int r = 0; r < 16; ++r) p1[r] = fmaf(p1[r], C, mnC);
#pragma unroll
  for (int r = 0; r < 16; ++r) p0[r] = __builtin_amdgcn_exp2f(p0[r]);
}
DI void finishSM(f32x16& p0, f32x16& p1, float alpha, float& l_reg, bf16x8& pa0, bf16x8& pa1, bf16x8& pa2, bf16x8& pa3) {
#pragma unroll
  for (int r = 0; r < 16; ++r) p1[r] = __builtin_amdgcn_exp2f(p1[r]);
  float ps = 0;
#pragma unroll
  for (int r = 0; r < 16; ++r) ps += p0[r];
#pragma unroll
  for (int r = 0; r < 16; ++r) ps += p1[r];
  { auto rr = __builtin_amdgcn_permlane32_swap(__float_as_uint(ps), __float_as_uint(ps), false, false);
    ps = __uint_as_float(rr[0]) + __uint_as_float(rr[1]); }
  l_reg = l_reg * alpha + ps;
#define PK4(Pv, BASE, OUT) do { unsigned a0 = cvtpk(Pv[BASE + 0], Pv[BASE + 1]), a1 = cvtpk(Pv[BASE + 2], Pv[BASE + 3]);   \
    unsigned b0 = cvtpk(Pv[BASE + 4], Pv[BASE + 5]), b1 = cvtpk(Pv[BASE + 6], Pv[BASE + 7]);                              \
    auto r0 = __builtin_amdgcn_permlane32_swap(a0, b0, false, false); auto r1 = __builtin_amdgcn_permlane32_swap(a1, b1, false, false); \
    u32x4 w = {r0[0], r1[0], r0[1], r1[1]}; OUT = *reinterpret_cast<bf16x8*>(&w); } while (0)
  PK4(p0, 0, pa0); PK4(p0, 8, pa1); PK4(p1, 0, pa2); PK4(p1, 8, pa3);
#undef PK4
}
DI void qkt(f32x16& p0, f32x16& p1, const char* Ks, const bf16x8* qr, int r32, int hi) {
#pragma unroll
  for (int r = 0; r < 16; ++r) { p0[r] = 0.f; p1[r] = 0.f; }
#pragma unroll
  for (int d0 = 0; d0 < 8; ++d0) { const int cb = (d0 * 16 + hi * 8) * 2;
    const bf16x8 b0 = *reinterpret_cast<const bf16x8*>(Ks + KSWZ(r32, cb));
    const bf16x8 b1 = *reinterpret_cast<const bf16x8*>(Ks + KSWZ(32 + r32, cb));
    p0 = __builtin_amdgcn_mfma_f32_32x32x16_bf16(b0, qr[d0], p0, 0, 0, 0);
    p1 = __builtin_amdgcn_mfma_f32_32x32x16_bf16(b1, qr[d0], p1, 0, 0, 0); }
}
DI int v_st(int k, int c) { const int kk = (k & ~0xC) | ((k & 4) << 1) | ((k & 8) >> 1); return ((kk >> 3) * 4 + (c >> 5)) * 512 + ((kk & 7) * 32 + (c & 31)) * 2; }
DI int v_rd_base(int lane) { return ((lane & 3) << 3) | (((lane >> 2) & 3) << 6) | (((lane >> 4) & 1) << 5) | (((lane >> 5) & 1) << 8); }
constexpr int v_rd_off(int d0, int ks, int half) { return d0 * 512 + ks * 4096 + half * 2048; }
template <int OFF> DI s16x4 tr_read(int vb) {
  s16x4 r; asm volatile("ds_read_b64_tr_b16 %0, %1 offset:%2" : "=&v"(r) : "v"(vb), "i"(OFF) : "memory"); return r;
}
template <int D0> DI void pv_one(f32x16& od, int vb, bf16x8 pa0, bf16x8 pa1, bf16x8 pa2, bf16x8 pa3) {
  const s16x4 l0 = tr_read<v_rd_off(D0, 0, 0)>(vb), h0 = tr_read<v_rd_off(D0, 0, 1)>(vb), l1 = tr_read<v_rd_off(D0, 1, 0)>(vb), h1 = tr_read<v_rd_off(D0, 1, 1)>(vb);
  const s16x4 l2 = tr_read<v_rd_off(D0, 2, 0)>(vb), h2 = tr_read<v_rd_off(D0, 2, 1)>(vb), l3 = tr_read<v_rd_off(D0, 3, 0)>(vb), h3 = tr_read<v_rd_off(D0, 3, 1)>(vb);
  asm volatile("s_waitcnt lgkmcnt(0)" ::: "memory"); SBAR();
#define PKV(L, H) (bf16x8){L[0], L[1], L[2], L[3], H[0], H[1], H[2], H[3]}
  od = __builtin_amdgcn_mfma_f32_32x32x16_bf16(pa0, PKV(l0, h0), od, 0, 0, 0);
  od = __builtin_amdgcn_mfma_f32_32x32x16_bf16(pa1, PKV(l1, h1), od, 0, 0, 0);
  od = __builtin_amdgcn_mfma_f32_32x32x16_bf16(pa2, PKV(l2, h2), od, 0, 0, 0);
  od = __builtin_amdgcn_mfma_f32_32x32x16_bf16(pa3, PKV(l3, h3), od, 0, 0, 0);
#undef PKV
}
DI void pv_d0(f32x16* o, int vb, bf16x8 pa0, bf16x8 pa1, bf16x8 pa2, bf16x8 pa3) {
  pv_one<0>(o[0], vb, pa0, pa1, pa2, pa3); pv_one<1>(o[1], vb, pa0, pa1, pa2, pa3); pv_one<2>(o[2], vb, pa0, pa1, pa2, pa3); pv_one<3>(o[3], vb, pa0, pa1, pa2, pa3);
}

DI void attn_unit(const bf16_t* __restrict__ Qb, const bf16_t* __restrict__ Kh, const bf16_t* __restrict__ Vh, bf16_t* __restrict__ Ob, int seq, char* lds, int tid_in) {
  const int tid = tid_in, wid = tid >> 6, lane = tid & 63, r32 = lane & 31, hi = lane >> 5;
  char* V_lds = lds; char* K_lds = lds + 2 * SHM_V;
  float* ws = (float*)(lds + 2 * SHM_V + 2 * SHM_K) + wid * 64; float* li_l = ws; float* al_l = ws + 32;
  float m_reg = -1e30f, l_reg = 0; f32x16 o[4]; bf16x8 qr[8];
#pragma unroll
  for (int d = 0; d < 4; ++d)
#pragma unroll
    for (int r = 0; r < 16; ++r) o[d][r] = 0.f;
  const bf16_t* Qw = Qb + (long)(wid * AQBLK + r32) * LDQ + hi * 8;
#pragma unroll
  for (int d0 = 0; d0 < 8; ++d0) qr[d0] = *(const bf16x8*)(Qw + d0 * 16);
  const int sr = tid >> 4, sc = (tid & 15) * 8, vst0 = v_st(sr, sc), vst1 = v_st(32 + sr, sc);
  const int vb0 = (int)(uintptr_t)V_lds + v_rd_base(lane);
  bf16x8 s0_vs0, s0_vs1, s0_ks0, s0_ks1, s1_vs0, s1_vs1, s1_ks0, s1_ks1;
  const unsigned koff = (unsigned)(sr * LDK + sc) * 2u;
  const char* const Kb = (const char*)Kh; const char* const Vb = (const char*)Vh;
#define SLOAD0(k0) do { const size_t tb = (size_t)(k0) * LDK * 2; \
    s0_vs0 = *(const bf16x8*)(Vb + tb + koff); s0_vs1 = *(const bf16x8*)(Vb + (tb + 32 * LDK * 2) + koff); \
    s0_ks0 = *(const bf16x8*)(Kb + tb + koff); s0_ks1 = *(const bf16x8*)(Kb + (tb + 32 * LDK * 2) + koff); } while (0)
#define SLOAD1(k0) do { const size_t tb = (size_t)(k0) * LDK * 2; \
    s1_vs0 = *(const bf16x8*)(Vb + tb + koff); s1_vs1 = *(const bf16x8*)(Vb + (tb + 32 * LDK * 2) + koff); \
    s1_ks0 = *(const bf16x8*)(Kb + tb + koff); s1_ks1 = *(const bf16x8*)(Kb + (tb + 32 * LDK * 2) + koff); } while (0)
#define SWRITE0(b) do { *(bf16x8*)(V_lds + (b) * SHM_V + vst0) = s0_vs0; *(bf16x8*)(V_lds + (b) * SHM_V + vst1) = s0_vs1; const int kc = sc * 2; \
    *(bf16x8*)(K_lds + (b) * SHM_K + KSWZ(sr, kc)) = s0_ks0; *(bf16x8*)(K_lds + (b) * SHM_K + KSWZ(32 + sr, kc)) = s0_ks1; } while (0)
#define SWRITE1(b) do { *(bf16x8*)(V_lds + (b) * SHM_V + vst0) = s1_vs0; *(bf16x8*)(V_lds + (b) * SHM_V + vst1) = s1_vs1; const int kc = sc * 2; \
    *(bf16x8*)(K_lds + (b) * SHM_K + KSWZ(sr, kc)) = s1_ks0; *(bf16x8*)(K_lds + (b) * SHM_K + KSWZ(32 + sr, kc)) = s1_ks1; } while (0)
#define SWAIT() asm volatile("s_waitcnt vmcnt(4)" ::: "memory")
#define RESC(a) do { if (__any((a) < 1.f)) { if (hi == 0) al_l[r32] = (a); asm volatile("s_waitcnt lgkmcnt(0)" ::: "memory"); \
    _Pragma("unroll") for (int d = 0; d < 4; ++d) _Pragma("unroll") for (int r = 0; r < 16; ++r) o[d][r] *= al_l[crow(r, hi)]; } } while (0)
  f32x16 pA0, pA1, pB0, pB1; float mnA, mnB, alA, alB; bf16x8 pa0, pa1, pa2, pa3; const int NT = seq / AKVBLK;
  SLOAD0(0); asm volatile("s_waitcnt vmcnt(0)" ::: "memory"); SWRITE0(0); __syncthreads();
  qkt(pA0, pA1, K_lds, qr, r32, hi); partialSM(pA0, pA1, m_reg, mnA, alA);
  SLOAD1(AKVBLK); if (2 < NT) SLOAD0(2 * AKVBLK);
  SWAIT(); SWRITE1(1); __syncthreads();
  if (__builtin_amdgcn_readfirstlane(wid) >= 4) __builtin_amdgcn_s_setprio(1);
  for (int j = 1; j + 1 < NT; j += 2) {
    SBAR(); qkt(pB0, pB1, K_lds + SHM_K, qr, r32, hi);
    finishSM(pA0, pA1, alA, l_reg, pa0, pa1, pa2, pa3); SBAR();
    SLOAD1((j + 2) * AKVBLK); SBAR();
    pv_d0(o, vb0, pa0, pa1, pa2, pa3); partialSM(pB0, pB1, m_reg, mnB, alB);
    __syncthreads(); SWAIT(); SWRITE0(0);
    RESC(alB); __syncthreads();
    SBAR(); qkt(pA0, pA1, K_lds, qr, r32, hi);
    finishSM(pB0, pB1, alB, l_reg, pa0, pa1, pa2, pa3); SBAR();
    if (j + 3 < NT) SLOAD0((j + 3) * AKVBLK); SBAR();
    pv_d0(o, vb0 + (int)SHM_V, pa0, pa1, pa2, pa3); partialSM(pA0, pA1, m_reg, mnA, alA);
    __syncthreads(); SWAIT(); SWRITE1(1);
    RESC(alA); __syncthreads();
  }
  SBAR(); qkt(pB0, pB1, K_lds + SHM_K, qr, r32, hi);
  finishSM(pA0, pA1, alA, l_reg, pa0, pa1, pa2, pa3); SBAR();
  pv_d0(o, vb0, pa0, pa1, pa2, pa3); partialSM(pB0, pB1, m_reg, mnB, alB);
  __syncthreads(); RESC(alB);
  finishSM(pB0, pB1, alB, l_reg, pa0, pa1, pa2, pa3); SBAR();
  pv_d0(o, vb0 + (int)SHM_V, pa0, pa1, pa2, pa3);
  if (hi == 0) li_l[r32] = l_reg; asm volatile("s_waitcnt lgkmcnt(0)" ::: "memory");
  float rli[16];
#pragma unroll
  for (int r = 0; r < 16; ++r) rli[r] = __builtin_amdgcn_rcpf(li_l[crow(r, hi)]);
  bf16_t* Ow = Ob + (long)(wid * AQBLK) * LDO;
#pragma unroll
  for (int r = 0; r < 16; ++r) { const int orow = crow(r, hi);
#pragma unroll
    for (int d0 = 0; d0 < 4; ++d0) Ow[(long)orow * LDO + d0 * 32 + r32] = f2bf(o[d0][r] * rli[r]); }
  __builtin_amdgcn_s_setprio(0);
#undef SLOAD0
#undef SLOAD1
#undef SWRITE0
#undef SWRITE1
#undef SWAIT
#undef RESC
  __syncthreads();
}

constexpr int RB64 = 144, RB128 = 272;
constexpr int L_KS = 0  , L_QS = 18432, L_KT = L_QS + 17408, L_VT = L_KT + 18432, L_TP = L_VT + 18432  ,
              L_QK = L_TP + 9216, L_AF = L_QK + 9216  , L_ST = L_AF + 17408, L_VS = L_ST + 34816  ,
              L_SM = L_VS + 18432, L_END = L_SM + 1344;
static_assert(L_END <= 163840, "LDS budget");
DI int swz128(int row, int chunk) { return row * RB64 + (chunk << 4); }
DI int swz256(int row, int chunk) { return row * RB128 + (chunk << 4); }
template <int RBA, int RBB, int KSTEPS> DI void mma_nt(f32x16& acc, const char* A, int arow, const char* Bt, int brow, int kh) {
#pragma unroll
  for (int s = 0; s < KSTEPS; ++s) {
    const int ch = 2 * s + kh;
    const bf16x8 a = *(const bf16x8*)(A + (RBA == 128 ? swz128(arow, ch) : swz256(arow, ch)));
    const bf16x8 b = *(const bf16x8*)(Bt + (RBB == 128 ? swz128(brow, ch) : swz256(brow, ch)));
    acc = __builtin_amdgcn_mfma_f32_32x32x16_bf16(a, b, acc, 0, 0, 0);
  }
}
DI bf16_t wordhalf(unsigned w, int h) { return (bf16_t)(h ? (w >> 16) : (w & 0xffffu)); }

DI void gdn_chain(const Params& P, int chain, char* lds, int tid_in) {
  const int tid = tid_in, wid = tid >> 6, lane = tid & 63, r32 = lane & 31, hi = lane >> 5;
  const int dir = chain & 1, head = (chain >> 1) & 3, seq = chain >> 3;
  const long base = seq < 8 ? (long)seq * TP : (long)MPROMPT + (long)(seq - 8) * TS;
  const int T = seq < 8 ? TP : TS, NC = T / 64;
  char* Ks = lds + L_KS; char* Qs = lds + L_QS; char* KT = lds + L_KT; char* VT = lds + L_VT; char* Tp = lds + L_TP; char* Tpp = lds + L_KS;
  char* QKm = lds + L_QK; char* NW = lds + L_AF; char* ST = lds + L_ST; char* VNT = lds + L_KS; char* VST = lds + L_VS;
  float* Af = (float*)(lds + L_AF); float* Tf = (float*)(lds + L_VS); float* Xs = (float*)(lds + L_TP);
  constexpr int AFS = 68;
  float* gcs = (float*)(lds + L_SM); float* betas = gcs + 64; float* egcs = gcs + 128; float* ees = gcs + 192; float* misc = gcs + 256;
  bf16_t* ob = dir ? P.ob : P.of;
  __syncthreads();
  for (int i = tid; i < 34816 / 16; i += 512) *(u32x4*)(ST + i * 16) = (u32x4){0u, 0u, 0u, 0u};
  f32x16 S0, S1;
#pragma unroll
  for (int r = 0; r < 16; ++r) { S0[r] = 0.f; S1[r] = 0.f; }
  const int lrow = lane, lch = wid * 2;
  u32x4 pq0, pq1, pk0, pk1, pv0, pv1; float pg = 0.f, pb = 0.f;
#define TOKOF(n, row) (base + (dir ? (long)(T - 1 - ((n) * 64 + (row))) : (long)((n) * 64 + (row))))
#define GLOADC(n) do { const long tk_ = TOKOF(n, lrow); const bf16_t* rp_ = P.qkvc + ((size_t)head * MTOK + (size_t)tk_) * 384 + lch * 8; \
    pq0 = *(const u32x4*)(rp_); pq1 = *(const u32x4*)(rp_ + 8); pk0 = *(const u32x4*)(rp_ + 128); pk1 = *(const u32x4*)(rp_ + 136); \
    pv0 = *(const u32x4*)(rp_ + 256); pv1 = *(const u32x4*)(rp_ + 264); \
    if (wid == 0) { const float* gp_ = P.gates + (size_t)tk_ * 16 + dir * 4 + head; pb = gp_[0]; pg = gp_[8]; } } while (0)
  GLOADC(0);
  __syncthreads();
  for (int n = 0; n < NC; ++n) {
    int tidv = tid_in; asm volatile("" : "+v"(tidv));
    const int tid = tidv, lane = tid & 63, r32 = lane & 31, hi = lane >> 5, lrow = lane;
    *(u32x4*)(Ks + swz256(lrow, lch)) = pk0; *(u32x4*)(Ks + swz256(lrow, lch + 1)) = pk1;
    *(u32x4*)(Qs + swz256(lrow, lch)) = pq0; *(u32x4*)(Qs + swz256(lrow, lch + 1)) = pq1;
    {
      const bool odd = (lane & 1) != 0; const int rb = (lrow & ~1) * 2;
#pragma unroll
      for (int w = 0; w < 4; ++w) {
        const int d = lch * 8 + 2 * w + (odd ? 1 : 0);
        { const unsigned self = pk0[w], oth = shxu(self, 1, lane); *(unsigned*)(KT + d * RB64 + rb) = odd ? ((oth >> 16) | (self & 0xffff0000u)) : ((self & 0xffffu) | (oth << 16)); }
        { const unsigned self = pk1[w], oth = shxu(self, 1, lane); *(unsigned*)(KT + (d + 8) * RB64 + rb) = odd ? ((oth >> 16) | (self & 0xffff0000u)) : ((self & 0xffffu) | (oth << 16)); }
        { const unsigned self = pv0[w], oth = shxu(self, 1, lane); *(unsigned*)(VT + d * RB64 + rb) = odd ? ((oth >> 16) | (self & 0xffff0000u)) : ((self & 0xffffu) | (oth << 16)); }
        { const unsigned self = pv1[w], oth = shxu(self, 1, lane); *(unsigned*)(VT + (d + 8) * RB64 + rb) = odd ? ((oth >> 16) | (self & 0xffff0000u)) : ((self & 0xffffu) | (oth << 16)); }
      }
    }
    if (wid == 0) {
      float c = pg;
#pragma unroll
      for (int o = 1; o < 64; o <<= 1) { const float t = __int_as_float(__builtin_amdgcn_ds_bpermute((lane >= o ? lane - o : lane) << 2, __float_as_int(c))); if (lane >= o) c += t; }
      const float gl = __int_as_float(__builtin_amdgcn_readlane(__float_as_int(c), 63));
      gcs[lane] = c; betas[lane] = pb; egcs[lane] = __expf(c); ees[lane] = __expf(gl - c); if (lane == 0) misc[0] = __expf(gl);
    }
    __syncthreads();
    {
      const int which = wid >> 2, mi = (wid >> 1) & 1, ni = wid & 1;
      f32x16 acc;
#pragma unroll
      for (int r = 0; r < 16; ++r) acc[r] = 0.f;
      if (which == 0) {
        if (mi >= ni) mma_nt<256, 256, 8>(acc, Ks, mi * 32 + r32, Ks, ni * 32 + r32, hi);
        const int j = ni * 32 + r32; const float gj = gcs[j];
#pragma unroll
        for (int r = 0; r < 16; ++r) {
          const int i = mi * 32 + crow(r, hi); const float dec = __expf(fminf(gcs[i] - gj, 0.f));
          Af[i * AFS + j] = (i > j) ? betas[i] * acc[r] * dec : 0.f;
        }
      } else {
        if (mi >= ni) mma_nt<256, 256, 8>(acc, Ks, ni * 32 + r32, Qs, mi * 32 + r32, hi);
        const int i = mi * 32 + r32; const float gi = gcs[i];
#pragma unroll
        for (int g = 0; g < 4; ++g) {
          const int j0 = ni * 32 + 8 * g + 4 * hi; float v[4];
#pragma unroll
          for (int e = 0; e < 4; ++e) { const int j = j0 + e; v[e] = (i >= j) ? acc[4 * g + e] * __expf(fminf(gi - gcs[j], 0.f)) : 0.f; }
          u32x2 w; w.x = cvtpk(v[0], v[1]); w.y = cvtpk(v[2], v[3]);
          *(u32x2*)(QKm + i * RB64 + j0 * 2) = w;
        }
      }
    }
    __syncthreads();
    if (wid == 0) {
      const int b = lane >> 4, c = lane & 15;
      const float* Ab = Af + (16 * b) * AFS + 16 * b;
      float t[16];
#pragma unroll
      for (int i = 0; i < 16; ++i) {
        float sacc = 0.f;
        asm volatile("" ::: "memory");
#pragma unroll
        for (int j4 = 0; j4 * 4 < i; ++j4) {
          const f32x4 a = *(const f32x4*)(Ab + i * AFS + j4 * 4);
#pragma unroll
          for (int e = 0; e < 4; ++e) if (j4 * 4 + e < i) sacc += a[e] * t[j4 * 4 + e];
        }
        t[i] = (i == c) ? 1.f : -sacc;
      }
#pragma unroll
      for (int i = 0; i < 16; ++i) Tf[(16 * b + i) * AFS + 16 * b + c] = t[i];
    } else {
      for (int e = tid - 64; e < 1536; e += 448) {
        const int blk = e >> 8, ii = (e >> 4) & 15, jj = e & 15;
        const int bi = blk < 3 ? 0 : (blk < 5 ? 1 : 2), bj = blk < 3 ? blk + 1 : (blk < 5 ? blk - 1 : 3);
        Tf[(16 * bi + ii) * AFS + 16 * bj + jj] = 0.f;
      }
    }
    __syncthreads();
#pragma unroll
    for (int d = 1; d <= 3; ++d) {
      const int nb = 4 - d;
      const int blk = tid >> 6, ii = (tid >> 2) & 15, j4 = (tid & 3) * 4, bi = blk + d, bj = blk;
      if (tid < nb * 64) {
        f32x4 sacc = (f32x4){0.f, 0.f, 0.f, 0.f};
        for (int bk = bj; bk < bi; ++bk)
#pragma unroll
          for (int k4 = 0; k4 < 4; ++k4) {
            const f32x4 a = *(const f32x4*)(Af + (16 * bi + ii) * AFS + 16 * bk + k4 * 4);
#pragma unroll
            for (int kk = 0; kk < 4; ++kk) sacc += a[kk] * *(const f32x4*)(Tf + (16 * bk + k4 * 4 + kk) * AFS + 16 * bj + j4);
          }
        *(f32x4*)(Xs + blk * 256 + ii * 16 + j4) = sacc;
      }
      __syncthreads();
      if (tid < nb * 64) {
        f32x4 sacc = (f32x4){0.f, 0.f, 0.f, 0.f};
#pragma unroll
        for (int k4 = 0; k4 < 4; ++k4) {
          const f32x4 a = *(const f32x4*)(Tf + (16 * bi + ii) * AFS + 16 * bi + k4 * 4);
#pragma unroll
          for (int kk = 0; kk < 4; ++kk) sacc += a[kk] * *(const f32x4*)(Xs + blk * 256 + (k4 * 4 + kk) * 16 + j4);
        }
        *(f32x4*)(Tf + (16 * bi + ii) * AFS + 16 * bj + j4) = -sacc;
      }
      __syncthreads();
    }
    {
      const int i = tid >> 3, c8 = tid & 7;
      const f32x4 t0 = *(const f32x4*)(Tf + i * AFS + c8 * 8), t1 = *(const f32x4*)(Tf + i * AFS + c8 * 8 + 4);
      const float tv[8] = {t0[0], t0[1], t0[2], t0[3], t1[0], t1[1], t1[2], t1[3]};
      u32x4 wp, wpp;
#pragma unroll
      for (int e = 0; e < 4; ++e) {
        const int j0 = c8 * 8 + 2 * e;
        const float a0 = tv[2 * e] * betas[j0], a1 = tv[2 * e + 1] * betas[j0 + 1];
        wp[e] = cvtpk(a0, a1); wpp[e] = cvtpk(a0 * egcs[j0], a1 * egcs[j0 + 1]);
      }
      *(u32x4*)(Tp + swz128(i, c8)) = wp; *(u32x4*)(Tpp + swz128(i, c8)) = wpp;
#pragma unroll
      for (int k = 0; k < 2; ++k) {
        const int c = tid + 512 * k, row = c >> 4, ch = c & 15; char* qp = Qs + swz256(row, ch);
        u32x4 v = *(u32x4*)qp; const float eg = egcs[row];
#pragma unroll
        for (int e = 0; e < 4; ++e) v[e] = cvtpk(bflo(v[e]) * eg, bfhi(v[e]) * eg);
        *(u32x4*)qp = v;
      }
    }
    __syncthreads();
    {
      const int mi = wid >> 2, ni = wid & 3;
      f32x16 acc;
#pragma unroll
      for (int r = 0; r < 16; ++r) acc[r] = 0.f;
      mma_nt<128, 128, 4>(acc, KT, ni * 32 + r32, Tpp, mi * 32 + r32, hi);
      const int i = mi * 32 + r32;
#pragma unroll
      for (int g = 0; g < 4; ++g) {
        const int dk0 = ni * 32 + 8 * g + 4 * hi;
        u32x2 w; w.x = cvtpk(-acc[4 * g], -acc[4 * g + 1]); w.y = cvtpk(-acc[4 * g + 2], -acc[4 * g + 3]);
        *(u32x2*)(NW + i * RB128 + dk0 * 2) = w;
      }
    }
    __syncthreads();
    if (n + 1 < NC) GLOADC(n + 1);
    {
      const int mi = wid >> 2, ni = wid & 3;
      f32x16 acc;
#pragma unroll
      for (int r = 0; r < 16; ++r) acc[r] = 0.f;
      mma_nt<128, 128, 4>(acc, Tp, mi * 32 + r32, VT, ni * 32 + r32, hi);
      mma_nt<256, 256, 8>(acc, NW, mi * 32 + r32, ST, ni * 32 + r32, hi);
      const int dv = ni * 32 + r32;
#pragma unroll
      for (int g = 0; g < 4; ++g) {
        const int i0 = mi * 32 + 8 * g + 4 * hi;
        u32x2 a, b;
        a.x = cvtpk(acc[4 * g], acc[4 * g + 1]); a.y = cvtpk(acc[4 * g + 2], acc[4 * g + 3]);
        b.x = cvtpk(acc[4 * g] * ees[i0], acc[4 * g + 1] * ees[i0 + 1]); b.y = cvtpk(acc[4 * g + 2] * ees[i0 + 2], acc[4 * g + 3] * ees[i0 + 3]);
        const int off = swz128(dv, i0 >> 3) + (i0 & 7) * 2;
        *(u32x2*)(VNT + off) = a; *(u32x2*)(VST + off) = b;
      }
    }
    __syncthreads();
    {
      const int mi = wid >> 2, ni = wid & 3;
      f32x16 acc;
#pragma unroll
      for (int r = 0; r < 16; ++r) acc[r] = 0.f;
      mma_nt<256, 256, 8>(acc, ST, ni * 32 + r32, Qs, mi * 32 + r32, hi);
      mma_nt<128, 128, 4>(acc, VNT, ni * 32 + r32, QKm, mi * 32 + r32, hi);
      {
        bf16_t* orow = ob + (size_t)TOKOF(n, mi * 32 + r32) * 512 + head * 128;
#pragma unroll
        for (int g = 0; g < 4; ++g) {
          const int dv0 = ni * 32 + 8 * g + 4 * hi;
          u32x2 w; w.x = cvtpk(acc[4 * g], acc[4 * g + 1]); w.y = cvtpk(acc[4 * g + 2], acc[4 * g + 3]);
          *(u32x2*)(orow + dv0) = w;
        }
      }
      const float egl = misc[0];
#pragma unroll
      for (int r = 0; r < 16; ++r) { S0[r] *= egl; S1[r] *= egl; }
      mma_nt<128, 128, 4>(S0, KT, (2 * mi) * 32 + r32, VST, ni * 32 + r32, hi);
      mma_nt<128, 128, 4>(S1, KT, (2 * mi + 1) * 32 + r32, VST, ni * 32 + r32, hi);
    }
    __syncthreads();
    {
      const int mi = wid >> 2, dv = (wid & 3) * 32 + r32;
#pragma unroll
      for (int g = 0; g < 4; ++g) {
        const int dk0 = (2 * mi) * 32 + 8 * g + 4 * hi, dk1 = dk0 + 32;
        u32x2 a, b;
        a.x = cvtpk(S0[4 * g], S0[4 * g + 1]); a.y = cvtpk(S0[4 * g + 2], S0[4 * g + 3]);
        b.x = cvtpk(S1[4 * g], S1[4 * g + 1]); b.y = cvtpk(S1[4 * g + 2], S1[4 * g + 3]);
        *(u32x2*)(ST + swz256(dv, dk0 >> 3) + (dk0 & 7) * 2) = a;
        *(u32x2*)(ST + swz256(dv, dk1 >> 3) + (dk1 & 7) * 2) = b;
      }
    }
  }
#undef TOKOF
#undef GLOADC
  __syncthreads();
}

DI int lane_id_now() { int l; asm volatile("v_mbcnt_lo_u32_b32 %0, -1, 0\n\tv_mbcnt_hi_u32_b32 %0, -1, %0" : "=v"(l)); return l; }
DI int grab_item(const Params& P, int* slot, int wsg) {
  __syncthreads();
  if (wsg == 0 && lane_id_now() == 0) *slot = (int)atomicAdd(P.ctr, 1u);
  __syncthreads();
  return __builtin_amdgcn_readfirstlane(*slot);
}
DI void phase3(const Params& P, char* lds, int tid_in, int limit) {
  int* slot = (int*)(lds + L_SM + 1280);
  const int wsg = __builtin_amdgcn_readfirstlane(tid_in >> 6);
  int w = grab_item(P, slot, wsg);
  while (w < 128) { gdn_chain(P, w, lds, wsg * 64 + lane_id_now()); w = grab_item(P, slot, wsg); }
  if (limit <= 128) return;
  asm volatile("" : "+s"(w));
  while (w < limit) {
    int u = w - 128; long base; int T, qb, head;
    if (u < 1024) { const int seq = u >> 7; head = ((u >> 6) & 1) * 2 + (u & 1); qb = (u >> 1) & 31; base = (long)seq * TP; T = TP; }
    else { u -= 1024; const int seq = u >> 5; head = ((u >> 4) & 1) * 2 + (u & 1); qb = (u >> 1) & 7; base = (long)MPROMPT + (long)seq * TS; T = TS; }
    const int kvh = head >> 1;
    const bf16_t* Qb = P.p + PSEG_Q + (size_t)(base + qb * 256) * 512 + head * 128;
    const bf16_t* Kh = P.kvc + ((size_t)kvh * MTOK + base) * 128;
    const bf16_t* Vh = P.kvc + ((size_t)(2 + kvh) * MTOK + base) * 128;
    bf16_t* Ob = P.mixed + (size_t)(base + qb * 256) * DM + 512 + head * 128;
    attn_unit(Qb, Kh, Vh, Ob, T, lds, wsg * 64 + lane_id_now());
    w = grab_item(P, slot, wsg);
  }
}

DI void phase3b(const Params& P, int tid_in) {
  const int tid = tid_in, wid = tid >> 6, lane = tid & 63, half = lane >> 5, c4 = (lane & 31) * 4;
  const int nwaves = gridDim.x * 8;
  const f32x4 gw = *(const f32x4*)(P.gnw + c4);
  constexpr int NB = 8;
  for (long it0 = (long)(blockIdx.x * 8 + wid) * (2 * NB); it0 < (long)MTOK * 4; it0 += (long)nwaves * (2 * NB)) {
    u32x2 uf[NB], ub[NB], uz[NB]; float o[NB][4], ss[NB];
#pragma unroll
    for (int k = 0; k < NB; ++k) {
      const long pr = it0 + 2 * k + half; const long m = pr >> 2; const int head = (int)(pr & 3);
      uf[k] = *(const u32x2*)(P.of + (size_t)m * 512 + head * 128 + c4);
      ub[k] = *(const u32x2*)(P.ob + (size_t)m * 512 + head * 128 + c4);
      uz[k] = *(const u32x2*)(P.p + PSEG_Z + (size_t)m * 512 + head * 128 + c4);
    }
#pragma unroll
    for (int k = 0; k < NB; ++k) {
      o[k][0] = bflo(uf[k].x) + bflo(ub[k].x); o[k][1] = bfhi(uf[k].x) + bfhi(ub[k].x); o[k][2] = bflo(uf[k].y) + bflo(ub[k].y); o[k][3] = bfhi(uf[k].y) + bfhi(ub[k].y);
      ss[k] = (o[k][0] * o[k][0] + o[k][1] * o[k][1]) + (o[k][2] * o[k][2] + o[k][3] * o[k][3]);
    }
#pragma unroll
    for (int os = 1; os <= 16; os <<= 1)
#pragma unroll
      for (int k = 0; k < NB; ++k) ss[k] = xsum_step(ss[k], os);
#pragma unroll
    for (int k = 0; k < NB; ++k) {
      const long pr = it0 + 2 * k + half; const long m = pr >> 2; const int head = (int)(pr & 3);
      const float rs = rsqrtf(ss[k] * (1.f / 128.f) + EPS);
      u32x2 w;
      w.x = cvtpk(o[k][0] * rs * gw[0] * silu(bflo(uz[k].x)), o[k][1] * rs * gw[1] * silu(bfhi(uz[k].x)));
      w.y = cvtpk(o[k][2] * rs * gw[2] * silu(bflo(uz[k].y)), o[k][3] * rs * gw[3] * silu(bfhi(uz[k].y)));
      *(u32x2*)(P.mixed + (size_t)m * DM + head * 128 + c4) = w;
    }
  }
}

DI void phase5(const Params& P, int tid_in) {
  const int tid = tid_in, wid = tid >> 6, lane = tid & 63;
  const int nwaves = gridDim.x * 8;
  f32x4 wp[4], wq[4];
#pragma unroll
  for (int j = 0; j < 4; ++j) { wp[j] = *(const f32x4*)(P.nmpost + j * 256 + lane * 4); wq[j] = *(const f32x4*)(P.nmlp + j * 256 + lane * 4); }
  for (int m = (blockIdx.x * 8 + wid) * 2; m < MTOK; m += nwaves * 2) {
    const float* xr = m < MPROMPT ? P.xp + (size_t)m * DM : P.xs + (size_t)(m - MPROMPT) * DM;
    f32x4 x[2][4], mx[2][4]; float ss[2] = {0.f, 0.f};
#pragma unroll
    for (int r = 0; r < 2; ++r)
#pragma unroll
      for (int j = 0; j < 4; ++j) {
        { const u32x2 ux = *(const u32x2*)(P.h + (size_t)(m + r) * DM + j * 256 + lane * 4); x[r][j] = (f32x4){bflo(ux.x), bfhi(ux.x), bflo(ux.y), bfhi(ux.y)}; }
        const u32x2 u = *(const u32x2*)(P.mix + (size_t)(m + r) * DM + j * 256 + lane * 4);
        mx[r][j] = (f32x4){bflo(u.x), bfhi(u.x), bflo(u.y), bfhi(u.y)};
      }
#pragma unroll
    for (int r = 0; r < 2; ++r)
#pragma unroll
      for (int j = 0; j < 4; ++j) ss[r] += mx[r][j][0] * mx[r][j][0] + mx[r][j][1] * mx[r][j][1] + mx[r][j][2] * mx[r][j][2] + mx[r][j][3] * mx[r][j][3];
#pragma unroll
    for (int o = 1; o <= 32; o <<= 1) { ss[0] = xsum_step(ss[0], o); ss[1] = xsum_step(ss[1], o); }
    float s2[2] = {0.f, 0.f};
#pragma unroll
    for (int r = 0; r < 2; ++r) {
      const float rs = rsqrtf(ss[r] * (1.f / DM) + EPS);
#pragma unroll
      for (int j = 0; j < 4; ++j) {
        x[r][j] = x[r][j] + mx[r][j] * rs * wp[j];
        { u32x2 wx; wx.x = cvtpk(x[r][j][0], x[r][j][1]); wx.y = cvtpk(x[r][j][2], x[r][j][3]); *(u32x2*)(P.x1b + (size_t)(m + r) * DM + j * 256 + lane * 4) = wx;
          x[r][j] = (f32x4){bflo(wx.x), bfhi(wx.x), bflo(wx.y), bfhi(wx.y)}; }
        s2[r] += x[r][j][0] * x[r][j][0] + x[r][j][1] * x[r][j][1] + x[r][j][2] * x[r][j][2] + x[r][j][3] * x[r][j][3];
      }
    }
#pragma unroll
    for (int o = 1; o <= 32; o <<= 1) { s2[0] = xsum_step(s2[0], o); s2[1] = xsum_step(s2[1], o); }
    if (lane < 2) P.rs2[m + lane] = rsqrtf((lane ? s2[1] : s2[0]) * (1.f / DM) + EPS);
  }
}

DI void phase8(const Params& P, int tid_in) {
  const int tid = tid_in, wid = tid >> 6, lane = tid & 63;
  const int nwaves = gridDim.x * 8;
  f32x4 wp[4];
#pragma unroll
  for (int j = 0; j < 4; ++j) wp[j] = *(const f32x4*)(P.nmlppost + j * 256 + lane * 4);
  for (int m = (blockIdx.x * 8 + wid) * 2; m < MTOK; m += nwaves * 2) {
    f32x4 x[2][4], mx[2][4]; float ss[2] = {0.f, 0.f};
#pragma unroll
    for (int r = 0; r < 2; ++r)
#pragma unroll
      for (int j = 0; j < 4; ++j) {
        { const u32x2 ux = *(const u32x2*)(P.x1b + (size_t)(m + r) * DM + j * 256 + lane * 4); x[r][j] = (f32x4){bflo(ux.x), bfhi(ux.x), bflo(ux.y), bfhi(ux.y)}; }
        const u32x2 u = *(const u32x2*)(P.f2 + (size_t)(m + r) * DM + j * 256 + lane * 4);
        mx[r][j] = (f32x4){bflo(u.x), bfhi(u.x), bflo(u.y), bfhi(u.y)};
      }
#pragma unroll
    for (int r = 0; r < 2; ++r)
#pragma unroll
      for (int j = 0; j < 4; ++j) ss[r] += mx[r][j][0] * mx[r][j][0] + mx[r][j][1] * mx[r][j][1] + mx[r][j][2] * mx[r][j][2] + mx[r][j][3] * mx[r][j][3];
#pragma unroll
    for (int o = 1; o <= 32; o <<= 1) { ss[0] = xsum_step(ss[0], o); ss[1] = xsum_step(ss[1], o); }
#pragma unroll
    for (int r = 0; r < 2; ++r) {
      const float rs = rsqrtf(ss[r] * (1.f / DM) + EPS);
#pragma unroll
      for (int j = 0; j < 4; ++j) __builtin_nontemporal_store(x[r][j] + mx[r][j] * rs * wp[j], (f32x4*)(P.out + (size_t)(m + r) * DM + j * 256 + lane * 4));
    }
  }
}


#define XB_TMO      128
#define XB_XCNT(j)  (256  + 64 * (j))
#define XB_XSUB(j)  (1280 + 64 * (j))
#define XB_XGEN(j)  (2304 + 64 * (j))
#define XB_TOP      3328
#define XB_TOPGEN   3392
#define XCD_BAR_WORDS 3456
#define XB_SPIN_CAP (1u << 18)
#define XLAS __attribute__((address_space(3)))
DI unsigned xb_ld(unsigned* p)              { return __hip_atomic_load(p, __ATOMIC_RELAXED, __HIP_MEMORY_SCOPE_AGENT); }
DI unsigned xb_add(unsigned* p, unsigned v) { return __hip_atomic_fetch_add(p, v, __ATOMIC_RELAXED, __HIP_MEMORY_SCOPE_AGENT); }
DI unsigned xb_xcc_id() { return (unsigned)__builtin_amdgcn_s_getreg((3 << 11) | 20) & 0xFu; }
#define XB_SPIN(cond, bar) do { unsigned _sp = 0; while (cond) { __builtin_amdgcn_s_sleep(1); \
    if ((++_sp & 255u) == 0u) { if (xb_ld(&(bar)[XB_TMO])) break; if (_sp > XB_SPIN_CAP) { atomicAdd(&(bar)[XB_TMO], 1u); break; } } } } while (0)
DI void xcd_barrier_complete(unsigned* bar, unsigned x, unsigned& nloc, unsigned& nx) {
  const unsigned G = gridDim.x * gridDim.y * gridDim.z;
  unsigned sum, cnt, mine, sp = 0u;
  for (;;) {
    sum = 0u; cnt = 0u; mine = 0u;
#pragma unroll
    for (unsigned j = 0; j < 16; ++j) { const unsigned c = xb_ld(&bar[XB_XCNT(j)]); sum += c; cnt += (c > 0u) ? 1u : 0u; mine = (j == x) ? c : mine; }
    if (sum == G) break;
    __builtin_amdgcn_s_sleep(1);
    if ((++sp & 255u) == 0u) { if (xb_ld(&bar[XB_TMO])) break; if (sp > XB_SPIN_CAP) { atomicAdd(&bar[XB_TMO], 1u); break; } }
  }
  nloc = mine > 0u ? mine : 1u; nx = cnt > 0u ? cnt : 1u;
}
DI void xcd_barrier(unsigned* bar, volatile XLAS unsigned* st, bool leader) {
  asm volatile("s_waitcnt vmcnt(0)" ::: "memory");
  __syncthreads();
  if (leader) {
    const unsigned x = xb_xcc_id();
    __builtin_amdgcn_s_waitcnt(0);
    unsigned nloc = st[0], nx = st[1];
    if (nloc == 0u) { xcd_barrier_complete(bar, x, nloc, nx); st[0] = nloc; st[1] = nx; }
    const unsigned old = xb_add(&bar[XB_XSUB(x)], 1u);
    const unsigned gen = old / nloc;
    if (old + 1u == (gen + 1u) * nloc) {
      __builtin_amdgcn_fence(__ATOMIC_RELEASE, "agent");
      asm volatile("s_waitcnt vmcnt(0)" ::: "memory");
      const unsigned og = xb_add(&bar[XB_TOP], 1u);
      const unsigned tg = og / nx;
      if (og + 1u == (tg + 1u) * nx) xb_add(&bar[XB_TOPGEN], 1u);
      else XB_SPIN(xb_ld(&bar[XB_TOPGEN]) == tg, bar);
      __builtin_amdgcn_fence(__ATOMIC_ACQUIRE, "agent");
      xb_add(&bar[XB_XGEN(x)], 1u);
      asm volatile("s_waitcnt vmcnt(0)" ::: "memory");
    } else {
      XB_SPIN(xb_ld(&bar[XB_XGEN(x)]) == gen, bar);
      __builtin_amdgcn_fence(__ATOMIC_ACQUIRE, "agent");
      asm volatile("s_waitcnt vmcnt(0)" ::: "memory");
    }
  }
  __syncthreads();
}

template <int PH> DI void run_phase(const Params& P, char* lds, int tid_in, int limit = 1408) {
  if constexpr (PH == 0) phase0(P, lds, tid_in);
  else if constexpr (PH == 1) gemm8<0, true>(P.h, DM, P.wt_in, DM, NIN, P.p, NIN, lds, tid_in, P.kvc, P.rs1);
  else if constexpr (PH == 2) phase2(P, tid_in);
  else if constexpr (PH == 3) phase3(P, lds, tid_in, limit);
  else if constexpr (PH == 4) phase3b(P, tid_in);
  else if constexpr (PH == 5) gemm8<0>(P.mixed, DM, P.wt_out, DM, DM, P.mix, DM, lds, tid_in);
  else if constexpr (PH == 6) phase5(P, tid_in);
  else if constexpr (PH == 7) gemm8<1, true>(P.x1b, DM, P.wt_up, DM, DFF, P.f, DFF, lds, tid_in, nullptr, P.rs2);
  else if constexpr (PH == 8) gemm8<0>(P.f, DFF, P.wt_down, DFF, DM, P.f2, DM, lds, tid_in);
  else if constexpr (PH == 9) phase8(P, tid_in);
  else if constexpr (PH == 10) { if (blockIdx.x == 0 && tid_in == 0) *P.ctr = (PROBE_MODE == 9) ? 128u : 0u; }
}

#if !ONE_LAUNCH
template <int PH> __global__ __launch_bounds__(512, 1) void phase_kernel(Params P) {
  extern __shared__ __attribute__((aligned(16))) char lds[];
  run_phase<PH>(P, lds, threadIdx.x);
}
#endif

#if ONE_LAUNCH
template <int PH> DI void mega_phase(char* lds, int wave_sgpr, int limit = 1408) {
#if defined(__HIP_DEVICE_COMPILE__)
  typedef const __attribute__((address_space(4))) unsigned long long* KWordPtr;
  KWordPtr pp = (KWordPtr)__builtin_amdgcn_kernarg_segment_ptr();
  asm volatile("" : "+s"(pp));
  constexpr int NW = sizeof(Params) / 8;
  union U { Params P; unsigned long long w[NW]; DI U() {} } u;
#pragma unroll
  for (int i = 0; i < NW; ++i) u.w[i] = pp[i];
  const Params& P = u.P;
  int lid;
  asm volatile("v_mbcnt_lo_u32_b32 %0, -1, 0\n\tv_mbcnt_hi_u32_b32 %0, -1, %0" : "=v"(lid));
  int tid = wave_sgpr * 64 + lid;
  asm volatile("" : "+v"(tid));
  run_phase<PH>(P, lds, tid, limit);
#endif
}
__global__ __launch_bounds__(512, 1) void mega_kernel(Params Pin) {
  extern __shared__ __attribute__((aligned(16))) char lds[];
  cg::grid_group grid = cg::this_grid();
  const int wave_sgpr = __builtin_amdgcn_readfirstlane((int)(threadIdx.x >> 6));
  volatile XLAS unsigned* xst = (volatile XLAS unsigned*)(XLAS unsigned char*)(lds + (LDS_BYTES - 16));
  if (threadIdx.x == 0) { xst[0] = 0u; xst[1] = 0u; (void)xb_add(&(Pin.ctr + 1024)[XB_XCNT(xb_xcc_id())], 1u); }
  __syncthreads();
#define GSYNC() do { typedef const __attribute__((address_space(4))) unsigned long long* KW_; KW_ pp_ = (KW_)__builtin_amdgcn_kernarg_segment_ptr(); asm volatile("" : "+s"(pp_)); \
    unsigned* bar_ = (unsigned*)pp_[offsetof(Params, ctr) / 8] + 1024; xcd_barrier(bar_, xst, wave_sgpr == 0 && lane_id_now() == 0); } while (0)
  if (Pin.out == nullptr) grid.sync();
  mega_phase<0>(lds, wave_sgpr); GSYNC();
  if (PROBE_MODE == 4 || PROBE_MODE == 5) { mega_phase<0>(lds, wave_sgpr); GSYNC(); }
  mega_phase<1>(lds, wave_sgpr); GSYNC();
  if (PROBE_MODE == 1) { mega_phase<1>(lds, wave_sgpr); GSYNC(); }
  mega_phase<2>(lds, wave_sgpr); GSYNC();
  {
    const int nrep = (PROBE_MODE == 3 || PROBE_MODE == 8 || PROBE_MODE == 9) ? ((Pin.ctr != nullptr) ? 2 : 1) : ((Pin.ctr != nullptr) ? 1 : 2);
    for (int rep = 0; rep < nrep; ++rep) {
      mega_phase<3>(lds, wave_sgpr, (rep == nrep - 1 || PROBE_MODE == 8 || PROBE_MODE == 9) ? 1408 : 128); GSYNC();
      if (rep < nrep - 1) { mega_phase<10>(lds, wave_sgpr); GSYNC(); }
    }
  }
  mega_phase<4>(lds, wave_sgpr); GSYNC();
  if (PROBE_MODE == 4) { mega_phase<4>(lds, wave_sgpr); GSYNC(); }
  mega_phase<5>(lds, wave_sgpr); GSYNC();
  if (PROBE_MODE == 1) { mega_phase<5>(lds, wave_sgpr); GSYNC(); }
  mega_phase<6>(lds, wave_sgpr); GSYNC();
  if (PROBE_MODE == 4 || PROBE_MODE == 6) { mega_phase<6>(lds, wave_sgpr); GSYNC(); }
  mega_phase<7>(lds, wave_sgpr); GSYNC();
  if (PROBE_MODE == 1) { mega_phase<7>(lds, wave_sgpr); GSYNC(); }
  mega_phase<8>(lds, wave_sgpr); GSYNC();
  if (PROBE_MODE == 1) { mega_phase<8>(lds, wave_sgpr); GSYNC(); }
  if (PROBE_MODE == 11) { for (int i = 0; i < 10; ++i) GSYNC(); }
  mega_phase<9>(lds, wave_sgpr);
  if (PROBE_MODE == 7) { grid.sync(); mega_phase<9>(lds, wave_sgpr); }
}
#endif

#if !ONE_LAUNCH
template <int PH> static void launch_phase(const Params& P, int grid, hipStream_t stream) {
  static bool attr = false;
  if (!attr) { (void)hipFuncSetAttribute((const void*)phase_kernel<PH>, hipFuncAttributeMaxDynamicSharedMemorySize, LDS_BYTES); attr = true; }
  hipLaunchKernelGGL(phase_kernel<PH>, dim3(grid), dim3(512), LDS_BYTES, stream, P);
}
#endif

extern "C" void kernel_launch(void* const* d_in, const int* in_sizes, int n_in, void* d_out, int out_size, void* d_ws, size_t ws_size, hipStream_t stream) {
  if (ws_size < WS_END) { fprintf(stderr, "kernel_launch: workspace too small: %zu < %zu\n", ws_size, WS_END); return; }
  Params P{};
  P.xp = (const float*)d_in[0]; P.xs = (const float*)d_in[1]; P.nmp = (const float*)d_in[2]; P.w_in = (const float*)d_in[3];
  P.conv_w = (const float*)d_in[4]; P.Alf = (const float*)d_in[5]; P.Alb = (const float*)d_in[6]; P.dtf = (const float*)d_in[7];
  P.dtb = (const float*)d_in[8]; P.gnw = (const float*)d_in[9]; P.qnw = (const float*)d_in[10]; P.knw = (const float*)d_in[11];
  P.w_out = (const float*)d_in[12]; P.nmpost = (const float*)d_in[13]; P.nmlp = (const float*)d_in[14]; P.w_up = (const float*)d_in[15];
  P.w_down = (const float*)d_in[16]; P.nmlppost = (const float*)d_in[17];
  P.out = (float*)d_out;
  char* ws = (char*)d_ws;
  P.wt_in = (bf16_t*)(ws + OFF_WT_IN); P.wt_out = (bf16_t*)(ws + OFF_WT_OUT); P.wt_up = (bf16_t*)(ws + OFF_WT_UP); P.wt_down = (bf16_t*)(ws + OFF_WT_DOWN);
  P.gates = (float*)(ws + OFF_GATES); P.ctr = (unsigned*)(ws + OFF_CTR); P.rs2 = (float*)(ws + OFF_CTR + 65536); P.rs1 = (float*)(ws + OFF_CTR + 65536 + 393216);
  P.h = (bf16_t*)(ws + OFF_H); P.of = (bf16_t*)d_out; P.ob = P.of + (size_t)MTOK * 512; P.mixed = P.of + (size_t)2 * MTOK * 512;         P.hm = P.h; P.f2 = P.h;
  P.p = (bf16_t*)(ws + OFF_P); P.f = P.p;
  P.qkvc = (bf16_t*)(ws + OFF_QKVC); P.mix = P.qkvc; P.x1b = (bf16_t*)(ws + OFF_X1B); P.kvc = (bf16_t*)(ws + OFF_KVC);
#if ONE_LAUNCH
  (void)hipMemsetAsync(ws + OFF_CTR, 0, 4096 + XCD_BAR_WORDS * 4, stream);
  static int grid_blocks = 0;
  if (!grid_blocks) {
    int dev = 0, cus = 0, per_cu = 0;
    (void)hipGetDevice(&dev);
    (void)hipDeviceGetAttribute(&cus, hipDeviceAttributeMultiprocessorCount, dev);
    (void)hipFuncSetAttribute((const void*)mega_kernel, hipFuncAttributeMaxDynamicSharedMemorySize, LDS_BYTES);
    (void)hipOccupancyMaxActiveBlocksPerMultiprocessor(&per_cu, mega_kernel, 512, LDS_BYTES);
    if (per_cu < 1) per_cu = 1;
    grid_blocks = cus * per_cu;
  }
  void* args[] = {&P};
  hipError_t e = hipLaunchCooperativeKernel((void*)mega_kernel, dim3(grid_blocks), dim3(512), args, LDS_BYTES, stream);
  if (e != hipSuccess) fprintf(stderr, "cooperative launch failed: %s (grid %d)\n", hipGetErrorString(e), grid_blocks);
#else
  const int grid = 256;
  launch_phase<0>(P, grid, stream); launch_phase<1>(P, grid, stream); launch_phase<2>(P, grid, stream); launch_phase<3>(P, grid, stream);
  launch_phase<4>(P, grid, stream); launch_phase<5>(P, grid, stream); launch_phase<6>(P, grid, stream); launch_phase<7>(P, grid, stream);
  launch_phase<8>(P, grid, stream); launch_phase<9>(P, grid, stream);
#endif
}
```
